# Optimizing an MI355X kernel written in HIP

```python
import jax, jax.numpy as jnp
from jax import lax
import numpy as np

D_MODEL = 1024
BATCH = 8
SEQ = 4096
DEPTH = 1
DEC_BATCH = 2
DEC_SEQ = 16384
PAST_LEN = 128

N_MEM = 256
D_CONV = 512
N_CONV_GROUPS = 8
CONV_WIDTH = 3
D_GMLP = 512
N_GMLP_HEADS = 8
GMLP_HEAD_DIM = D_GMLP // N_GMLP_HEADS
CHUNK = 128
D_IN = 3 * D_CONV + 2 * D_GMLP
D_MIX = D_CONV + D_GMLP
D_FF = 2816
N_XHEADS = 4
XHEAD_DIM = D_MODEL // N_XHEADS
EPS = 1e-6

kernel_name = "hybrid_conv_gmlp_macaron_encoder"


def rms_norm(x, g):
    xf = x.astype(jnp.float32)
    y = xf * lax.rsqrt(jnp.mean(xf * xf, axis=-1, keepdims=True) + EPS)
    return (y * g.astype(jnp.float32)).astype(x.dtype)


def layer_norm(x, g, b):
    xf = x.astype(jnp.float32)
    mu = jnp.mean(xf, axis=-1, keepdims=True)
    xc = xf - mu
    y = xc * lax.rsqrt(jnp.mean(xc * xc, axis=-1, keepdims=True) + EPS)
    return (y * g.astype(jnp.float32) + b.astype(jnp.float32)).astype(x.dtype)


def swiglu(x, w_gu, w_down):
    g, u = jnp.split(x @ w_gu, 2, axis=-1)
    return (jax.nn.silu(g) * u) @ w_down


def short_conv(z, w):
    zp = jnp.pad(z, ((0, 0), (1, 1), (0, 0)))
    return w[0] * zp[:, :-2] + w[1] * zp[:, 1:-1] + w[2] * zp[:, 2:]


def spatial_gate(u, v, w_s, b_s, ln_g, ln_b):
    bsz, s, _ = v.shape
    v = layer_norm(v, ln_g, ln_b)
    vc = v.reshape(bsz, s // CHUNK, CHUNK, N_GMLP_HEADS, GMLP_HEAD_DIM)
    mixed = jnp.einsum('hpq,bcqhd->bcphd', w_s, vc) + b_s.T[None, None, :, :, None]
    return u * mixed.reshape(bsz, s, D_GMLP)


def cross_attention(h, mem_n, w_q, w_kv, w_o):
    bsz, s, _ = h.shape
    q = (h @ w_q).reshape(bsz, s, N_XHEADS, XHEAD_DIM)
    k, v = jnp.split(mem_n @ w_kv, 2, axis=-1)
    k = k.reshape(bsz, N_MEM, N_XHEADS, XHEAD_DIM)
    v = v.reshape(bsz, N_MEM, N_XHEADS, XHEAD_DIM)
    scores = jnp.einsum('bshd,bmhd->bhsm', q, k).astype(jnp.float32) * (XHEAD_DIM ** -0.5)
    attn = jax.nn.softmax(scores, axis=-1).astype(v.dtype)
    o = jnp.einsum('bhsm,bmhd->bshd', attn, v).reshape(bsz, s, D_MODEL)
    return o @ w_o


def encoder_layer(x, mem, p, i):
    x = x + 0.5 * swiglu(rms_norm(x, p['norm_ffn1'][i]), p['ffn1_w_gu'][i], p['ffn1_w_down'][i])
    n = rms_norm(x, p['norm_mix'][i])
    proj = n @ p['w_in'][i]
    b_gate, c_gate, x_in, u, v = jnp.split(
        proj, [D_CONV, 2 * D_CONV, 3 * D_CONV, 3 * D_CONV + D_GMLP], axis=-1)
    y_conv = b_gate * short_conv(c_gate * x_in, p['conv_w'][i])
    y_gmlp = spatial_gate(jax.nn.gelu(u), jax.nn.gelu(v), p['gmlp_w_s'][i], p['gmlp_b_s'][i],
                          p['gmlp_ln_g'][i], p['gmlp_ln_b'][i])
    y_mix = jnp.concatenate([rms_norm(y_conv, p['norm_conv_out'][i]),
                             rms_norm(y_gmlp, p['norm_gmlp_out'][i])], axis=-1)
    x = x + y_mix @ p['w_out'][i]
    mem_n = rms_norm(mem, p['norm_mem'][i])
    x = x + cross_attention(rms_norm(x, p['norm_cross'][i]), mem_n,
                            p['xattn_w_q'][i], p['xattn_w_kv'][i], p['xattn_w_o'][i])
    x = x + 0.5 * swiglu(rms_norm(x, p['norm_ffn2'][i]), p['ffn2_w_gu'][i], p['ffn2_w_down'][i])
    return x


def encoder(x, mem, p, norm_final):
    for i in range(DEPTH):
        x = encoder_layer(x, mem, p, i)
    return rms_norm(x, norm_final)


def setup_inputs(seed: int = 0) -> dict:
    key = jax.random.key(seed)
    ks = jax.random.split(key, 32)
    f32 = jnp.float32
    nrm = lambda k, shape, scale: (jax.random.normal(k, shape, f32) * scale)
    gain = lambda k, shape: 1.0 + 0.02 * jax.random.normal(k, shape, f32)
    L = DEPTH
    return {
        'x_prompt': nrm(ks[0], (BATCH, SEQ, D_MODEL), 1.0),
        'x_sample': nrm(ks[1], (DEC_BATCH, DEC_SEQ, D_MODEL), 1.0),
        'mem_prompt': nrm(ks[2], (BATCH, N_MEM, D_MODEL), 1.0),
        'mem_sample': nrm(ks[3], (DEC_BATCH, N_MEM, D_MODEL), 1.0),
        'norm_ffn1': gain(ks[4], (L, D_MODEL)),
        'ffn1_w_gu': nrm(ks[5], (L, D_MODEL, 2 * D_FF), D_MODEL ** -0.5),
        'ffn1_w_down': nrm(ks[6], (L, D_FF, D_MODEL), D_FF ** -0.5),
        'norm_mix': gain(ks[7], (L, D_MODEL)),
        'w_in': nrm(ks[8], (L, D_MODEL, D_IN), D_MODEL ** -0.5),
        'conv_w': nrm(ks[9], (L, CONV_WIDTH, D_CONV), CONV_WIDTH ** -0.5),
        'gmlp_w_s': nrm(ks[10], (L, N_GMLP_HEADS, CHUNK, CHUNK), CHUNK ** -0.5),
        'gmlp_b_s': gain(ks[11], (L, N_GMLP_HEADS, CHUNK)),
        'gmlp_ln_g': gain(ks[12], (L, D_GMLP)),
        'gmlp_ln_b': nrm(ks[13], (L, D_GMLP), 0.02),
        'norm_conv_out': gain(ks[14], (L, D_CONV)),
        'norm_gmlp_out': gain(ks[15], (L, D_GMLP)),
        'w_out': nrm(ks[16], (L, D_MIX, D_MODEL), D_MIX ** -0.5),
        'norm_mem': gain(ks[17], (L, D_MODEL)),
        'norm_cross': gain(ks[18], (L, D_MODEL)),
        'xattn_w_q': nrm(ks[19], (L, D_MODEL, D_MODEL), D_MODEL ** -0.5),
        'xattn_w_kv': nrm(ks[20], (L, D_MODEL, 2 * D_MODEL), D_MODEL ** -0.5),
        'xattn_w_o': nrm(ks[21], (L, D_MODEL, D_MODEL), D_MODEL ** -0.5),
        'norm_ffn2': gain(ks[22], (L, D_MODEL)),
        'ffn2_w_gu': nrm(ks[23], (L, D_MODEL, 2 * D_FF), D_MODEL ** -0.5),
        'ffn2_w_down': nrm(ks[24], (L, D_FF, D_MODEL), D_FF ** -0.5),
        'norm_final': gain(ks[25], (D_MODEL,)),
    }


def reference(x_prompt, x_sample, mem_prompt, mem_sample,
              norm_ffn1, ffn1_w_gu, ffn1_w_down, norm_mix, w_in, conv_w,
              gmlp_w_s, gmlp_b_s, gmlp_ln_g, gmlp_ln_b, norm_conv_out, norm_gmlp_out,
              w_out, norm_mem, norm_cross, xattn_w_q, xattn_w_kv, xattn_w_o,
              norm_ffn2, ffn2_w_gu, ffn2_w_down, norm_final):
    p = dict(norm_ffn1=norm_ffn1, ffn1_w_gu=ffn1_w_gu, ffn1_w_down=ffn1_w_down,
             norm_mix=norm_mix, w_in=w_in, conv_w=conv_w,
             gmlp_w_s=gmlp_w_s, gmlp_b_s=gmlp_b_s, gmlp_ln_g=gmlp_ln_g, gmlp_ln_b=gmlp_ln_b,
             norm_conv_out=norm_conv_out, norm_gmlp_out=norm_gmlp_out, w_out=w_out,
             norm_mem=norm_mem, norm_cross=norm_cross, xattn_w_q=xattn_w_q,
             xattn_w_kv=xattn_w_kv, xattn_w_o=xattn_w_o,
             norm_ffn2=norm_ffn2, ffn2_w_gu=ffn2_w_gu, ffn2_w_down=ffn2_w_down)
    y_prompt = encoder(x_prompt, mem_prompt, p, norm_final)
    y_sample = encoder(x_sample, mem_sample, p, norm_final)
    return (y_prompt, y_sample)
```

```cpp
#include <hip/hip_runtime.h>
#include <hip/hip_cooperative_groups.h>
#include <cstdio>
#include <cstdint>
namespace cg = cooperative_groups;

#define LAS __attribute__((address_space(3)))
#define GAS __attribute__((address_space(1)))
typedef unsigned short bf16_t;
typedef short bf16x8 __attribute__((ext_vector_type(8)));
typedef float f32x4 __attribute__((ext_vector_type(4)));
typedef unsigned u32x4 __attribute__((ext_vector_type(4)));
typedef unsigned u32x2 __attribute__((ext_vector_type(2)));

constexpr int T_TOK = 65536, T_HALF = 32768, DM = 1024, DFF = 2816, NGU = 5632, DIN = 2560, NMEMROWS = 2560;
constexpr float EPS = 1e-6f;
constexpr float LOG2E = 1.4426950408889634f;

constexpr size_t MiB = 1u << 20;
constexpr size_t WS_SS = 0;
constexpr size_t WS_BAR = 1536 * 1024;
constexpr size_t WS_WGU1 = 2 * MiB;
constexpr size_t WS_WD1 = 13 * MiB;
constexpr size_t WS_WIN = 19 * MiB;
constexpr size_t WS_WOUT = 24 * MiB;
constexpr size_t WS_WQ = 26 * MiB;
constexpr size_t WS_WKV = 28 * MiB;
constexpr size_t WS_WO = 32 * MiB;
constexpr size_t WS_WSB = 34 * MiB;
constexpr size_t WS_MEMN = 35 * MiB;
constexpr size_t WS_KMAT = 40 * MiB;
constexpr size_t WS_VT = 45 * MiB;
constexpr size_t WS_WGU2 = 51 * MiB;
constexpr size_t WS_WD2 = 62 * MiB;
constexpr size_t WS_H2TAIL = 2 * MiB;
constexpr size_t WS_XBUF = 40 * MiB;
constexpr size_t WS_CNT = 1280 * 1024;
constexpr size_t WS_R1 = 68 * MiB;
constexpr size_t WS_R2 = 196 * MiB;
constexpr size_t WS_END = 512 * MiB;

__device__ __forceinline__ unsigned cvt_pk_bf16(float lo, float hi) { unsigned r; asm("v_cvt_pk_bf16_f32 %0, %1, %2" : "=v"(r) : "v"(lo), "v"(hi)); return r; }
__device__ __forceinline__ float bf_lo(unsigned u) { return __uint_as_float(u << 16); }
__device__ __forceinline__ float bf_hi(unsigned u) { return __uint_as_float(u & 0xffff0000u); }
__device__ __forceinline__ float wave_sum(float v) {
#pragma unroll
    for (int o = 1; o < 64; o <<= 1) v += __shfl_xor(v, o);
    return v;
}
__device__ __forceinline__ float fast_sigmoid_mul(float x, float z) {
    return x * __builtin_amdgcn_rcpf(1.0f + __builtin_amdgcn_exp2f(-z * LOG2E));
}
typedef float f32x2 __attribute__((ext_vector_type(2)));
__device__ __forceinline__ f32x2 sigmoid_mul_pk(f32x2 x, f32x2 z) {
    const f32x2 t = z * (-LOG2E); f32x2 e; e.x = __builtin_amdgcn_exp2f(t.x); e.y = __builtin_amdgcn_exp2f(t.y);
    const f32x2 d = e + 1.0f; f32x2 r; r.x = __builtin_amdgcn_rcpf(d.x); r.y = __builtin_amdgcn_rcpf(d.y);
    return x * r;
}
__device__ __forceinline__ f32x2 gelu_tanh_pk(f32x2 x) { return sigmoid_mul_pk(x, (x * x * 0.044715f + 1.0f) * x * 1.5957691216057308f); }
__device__ __forceinline__ float gelu_tanh(float x) { return fast_sigmoid_mul(x, 1.5957691216057308f * (x + 0.044715f * x * x * x)); }
__device__ __forceinline__ float silu(float x) { return fast_sigmoid_mul(x, x); }

namespace pg8 {
constexpr int BM = 256, BK = 64, HALF = 128, HTB = HALF * BK * 2, STAGE_BYTES = 8 * HTB, NXCD = 8, WGM = 8;

__host__ __device__ __forceinline__ int lds_byte(int r, int c) { const int st = (r >> 4) * 2 + (c >> 5), rr = r & 15, cc = c & 31, ob = rr * 64 + cc * 2; return st * 1024 + (ob ^ (((ob >> 9) & 1) << 5)); }
__host__ __device__ __forceinline__ void stage_rc(int b, int& R, int& C) { const int st = b / 1024, sb = b % 1024, swz = sb ^ (((sb >> 9) & 1) << 5); R = (st >> 1) * 16 + swz / 64; C = (st & 1) * 32 + (swz % 64) / 2; }
__host__ __device__ __forceinline__ int perm32(int rho) { const int n = rho >> 4, i = rho & 15; return 8 * (i >> 2) + 4 * n + (i & 3); }

struct Unit { int pm, pn; const GAS char* A; const GAS char* B; };
struct Gemm { int lda, ldb, K; };

struct Order {
    int nM, nN, nwg, G, c, pm0;
    const GAS char* A; const GAS char* A2; const GAS char* B; unsigned tA, cA, tB, bB; int pmsplit;
    __device__ __forceinline__ void init(int nM_, int nN_, int G_, int c_, int pm0_, const GAS void* A_, unsigned tA_, unsigned cA_, const GAS void* B_, unsigned tB_, unsigned bB_) {
        nM = nM_; nN = nN_; nwg = nM_ * nN_; G = G_; c = c_; pm0 = pm0_; A = (const GAS char*)A_; A2 = A; pmsplit = 1 << 30; B = (const GAS char*)B_; tA = tA_; cA = cA_; tB = tB_; bB = bB_;
    }
    __device__ __forceinline__ bool next(int i, Unit& u) const {
        const long L = (long)i * G + c; if (L >= nwg) return false;
        int wgid = (int)L; { const int q = nwg / NXCD, r = nwg % NXCD, xcd = wgid % NXCD, off = wgid / NXCD; wgid = (xcd < r ? xcd * (q + 1) : r * (q + 1) + (xcd - r) * q) + off; }
        const int nig = WGM * nN, gid = wgid / nig, fm = gid * WGM, gsz = (nM - fm) < WGM ? (nM - fm) : WGM;
        u.pm = pm0 + fm + ((wgid % nig) % gsz); u.pn = (wgid % nig) / gsz;
        const int b = u.pm < 128 ? (u.pm >> 4) : 8 + ((u.pm - 128) >> 6);
        u.A = (u.pm < pmsplit ? A : A2) + (size_t)u.pm * tA + (size_t)u.pn * cA;
        u.B = B + (size_t)u.pn * tB + (size_t)b * bB;
        return true;
    }
};

struct ScNext { float nv; LAS float* dst; bool pf; };
template <bool SS> struct EpiPlain {
    static constexpr bool SSPRE = SS;
    GAS bf16_t* O; int ldc; const GAS float* ss;
    __device__ __forceinline__ void operator()(f32x4 (&acc)[2][2][4][2], const Unit& u, int wr, int wc, int fr, int fq, const LAS float* sc = nullptr, const ScNext nx = ScNext{0.f, nullptr, false}) const {
        const int row0 = u.pm * BM + wr * 64 + fr, col0 = u.pn * BM + wc * 32 + 8 * fq;
        float rs_[2][4];
#pragma unroll
        for (int ai = 0; ai < 2; ++ai)
#pragma unroll
            for (int m = 0; m < 4; ++m) rs_[ai][m] = SS ? sc[ai * HALF + wr * 64 + m * 16 + fr] : 1.0f;
#pragma unroll
        for (int ai = 0; ai < 2; ++ai)
#pragma unroll
            for (int m = 0; m < 4; ++m) {
                if (ai == 1 && m == 0) { if (nx.pf) *nx.dst = __builtin_amdgcn_rsqf(nx.nv * (1.0f / 1024.0f) + EPS); }
                const int r = row0 + ai * HALF + m * 16; const float s = rs_[ai][m];
                GAS bf16_t* rowp = O + (size_t)r * ldc + col0;
#pragma unroll
                for (int bj = 0; bj < 2; ++bj) {
                    const f32x4 v0 = acc[ai][bj][m][0] * s, v1 = acc[ai][bj][m][1] * s;
                    u32x4 w; w.x = cvt_pk_bf16(v0[0], v0[1]); w.y = cvt_pk_bf16(v0[2], v0[3]); w.z = cvt_pk_bf16(v1[0], v1[1]); w.w = cvt_pk_bf16(v1[2], v1[3]);
                    *(GAS u32x4*)(rowp + bj * HALF) = w;
                }
            }
    }
};
struct EpiGU {      static constexpr bool SSPRE = true;
    GAS bf16_t* Hh; GAS bf16_t* Hh2; int pmsplit; const GAS float* ss;
    __device__ __forceinline__ void operator()(f32x4 (&acc)[2][2][4][2], const Unit& u, int wr, int wc, int fr, int fq, const LAS float* sc, const ScNext nx) const {
        const int row0 = u.pm * BM + wr * 64 + fr, col0 = u.pn * HALF + wc * 32 + 8 * fq;
        GAS bf16_t* Hb = u.pm < pmsplit ? Hh : Hh2;
        float rs_[2][4];
#pragma unroll
        for (int ai = 0; ai < 2; ++ai)
#pragma unroll
            for (int m = 0; m < 4; ++m) rs_[ai][m] = sc[ai * HALF + wr * 64 + m * 16 + fr];
#pragma unroll
        for (int ai = 0; ai < 2; ++ai)
#pragma unroll
            for (int m = 0; m < 4; ++m) {
                if (ai == 1 && m == 0) { if (nx.pf) *nx.dst = __builtin_amdgcn_rsqf(nx.nv * (1.0f / 1024.0f) + EPS); }
                const int r = row0 + ai * HALF + m * 16; const float s = rs_[ai][m];
                f32x2 o[4];
#pragma unroll
                for (int n = 0; n < 2; ++n)
#pragma unroll
                    for (int h2 = 0; h2 < 2; ++h2) { const f32x4 ga = acc[ai][0][m][n], ua = acc[ai][1][m][n];
                        const f32x2 g = (f32x2){ga[2 * h2], ga[2 * h2 + 1]} * s, uu = (f32x2){ua[2 * h2], ua[2 * h2 + 1]} * s; o[n * 2 + h2] = sigmoid_mul_pk(g, g) * uu; }
                u32x4 w; w.x = cvt_pk_bf16(o[0].x, o[0].y); w.y = cvt_pk_bf16(o[1].x, o[1].y); w.z = cvt_pk_bf16(o[2].x, o[2].y); w.w = cvt_pk_bf16(o[3].x, o[3].y);
                __builtin_nontemporal_store(w, (GAS u32x4*)(Hb + (size_t)r * DFF + col0));
            }
    }
};
struct EpiWin {     static constexpr bool SSPRE = true;
    GAS bf16_t* O; const GAS float* ss;
    __device__ __forceinline__ void operator()(f32x4 (&acc)[2][2][4][2], const Unit& u, int wr, int wc, int fr, int fq, const LAS float* sc, const ScNext nx) const {
        const int row0 = u.pm * BM + wr * 64 + fr, cw = wc * 32 + 8 * fq, pn = u.pn;
        float rs_[2][4];
#pragma unroll
        for (int ai = 0; ai < 2; ++ai)
#pragma unroll
            for (int m = 0; m < 4; ++m) rs_[ai][m] = sc[ai * HALF + wr * 64 + m * 16 + fr];
#pragma unroll
        for (int ai = 0; ai < 2; ++ai)
#pragma unroll
            for (int m = 0; m < 4; ++m) {
                if (ai == 1 && m == 0) { if (nx.pf) *nx.dst = __builtin_amdgcn_rsqf(nx.nv * (1.0f / 1024.0f) + EPS); }
                const int r = row0 + ai * HALF + m * 16; const float s = rs_[ai][m];
                GAS bf16_t* rowp = O + (size_t)r * 2048;
                if (pn < 2) {
#pragma unroll
                    for (int bj = 0; bj < 2; ++bj) {
                        const f32x4 v0 = acc[ai][bj][m][0] * s, v1 = acc[ai][bj][m][1] * s;
                        u32x4 w; w.x = cvt_pk_bf16(v0[0], v0[1]); w.y = cvt_pk_bf16(v0[2], v0[3]); w.z = cvt_pk_bf16(v1[0], v1[1]); w.w = cvt_pk_bf16(v1[2], v1[3]);
                        __builtin_nontemporal_store(w, (GAS u32x4*)(rowp + pn * 256 + bj * HALF + cw));
                    }
                } else if (pn < 6) {
                    const f32x4 v0 = (acc[ai][0][m][0] * s) * (acc[ai][1][m][0] * s), v1 = (acc[ai][0][m][1] * s) * (acc[ai][1][m][1] * s);
                    u32x4 w; w.x = cvt_pk_bf16(v0[0], v0[1]); w.y = cvt_pk_bf16(v0[2], v0[3]); w.z = cvt_pk_bf16(v1[0], v1[1]); w.w = cvt_pk_bf16(v1[2], v1[3]);
                    __builtin_nontemporal_store(w, (GAS u32x4*)(rowp + 512 + (pn - 2) * HALF + cw));
                } else {
#pragma unroll
                    for (int bj = 0; bj < 2; ++bj) {
                        f32x2 o[4];
#pragma unroll
                        for (int n = 0; n < 2; ++n)
#pragma unroll
                            for (int h2 = 0; h2 < 2; ++h2) { const f32x4 xa = acc[ai][bj][m][n]; o[n * 2 + h2] = gelu_tanh_pk((f32x2){xa[2 * h2], xa[2 * h2 + 1]} * s); }
                        u32x4 w; w.x = cvt_pk_bf16(o[0].x, o[0].y); w.y = cvt_pk_bf16(o[1].x, o[1].y); w.z = cvt_pk_bf16(o[2].x, o[2].y); w.w = cvt_pk_bf16(o[3].x, o[3].y);
                        __builtin_nontemporal_store(w, (GAS u32x4*)(rowp + 1024 + (pn - 6) * 256 + bj * HALF + cw));
                    }
                }
            }
    }
};
template <bool BASE_F32> struct EpiRes {   static constexpr bool SSPRE = false;
    const GAS void* base; const GAS void* base2; GAS bf16_t* xb; GAS float* ssout; float alpha;
    __device__ __forceinline__ void operator()(f32x4 (&acc)[2][2][4][2], const Unit& u, int wr, int wc, int fr, int fq) const {
        const int row0 = u.pm * BM + wr * 64 + fr, col0 = u.pn * BM + wc * 32 + 8 * fq;
        const GAS void* bs = u.pm < 128 ? base : base2;
        if constexpr (BASE_F32) {
#pragma unroll
            for (int am = 0; am < 4; ++am) {
                const int ai = am >> 1, mh = am & 1;
                f32x4 bv[2][2][2];
#pragma unroll
                for (int mm = 0; mm < 2; ++mm)
#pragma unroll
                    for (int bj = 0; bj < 2; ++bj) { const size_t off = (size_t)(row0 + ai * HALF + (2 * mh + mm) * 16) * DM + col0 + bj * HALF;
                        bv[mm][bj][0] = *(const GAS f32x4*)((const GAS float*)bs + off); bv[mm][bj][1] = *(const GAS f32x4*)((const GAS float*)bs + off + 4); }
                asm volatile("" ::: "memory");
#pragma unroll
                for (int mm = 0; mm < 2; ++mm) {
                    const int m = 2 * mh + mm;
                    const int r = row0 + ai * HALF + m * 16; const size_t off = (size_t)r * DM + col0; float q = 0.f;
#pragma unroll
                    for (int bj = 0; bj < 2; ++bj) {
                        const f32x4 o0 = bv[mm][bj][0] + acc[ai][bj][m][0] * alpha, o1 = bv[mm][bj][1] + acc[ai][bj][m][1] * alpha;
                        q += (o0[0] * o0[0] + o0[1] * o0[1]) + (o0[2] * o0[2] + o0[3] * o0[3]) + (o1[0] * o1[0] + o1[1] * o1[1]) + (o1[2] * o1[2] + o1[3] * o1[3]);
                        u32x4 w; w.x = cvt_pk_bf16(o0[0], o0[1]); w.y = cvt_pk_bf16(o0[2], o0[3]); w.z = cvt_pk_bf16(o1[0], o1[1]); w.w = cvt_pk_bf16(o1[2], o1[3]);
                        *(GAS u32x4*)(xb + off + bj * HALF) = w;
                    }
                    q += __shfl_xor(q, 16); q += __shfl_xor(q, 32); if (fq == 0) __builtin_amdgcn_global_atomic_fadd_f32(ssout + r, q);
                }
            }
        } else {
#pragma unroll
            for (int ai = 0; ai < 2; ++ai) {
                u32x4 bv[4][2];
#pragma unroll
                for (int m = 0; m < 4; ++m)
#pragma unroll
                    for (int bj = 0; bj < 2; ++bj) bv[m][bj] = *(const GAS u32x4*)((const GAS bf16_t*)bs + (size_t)(row0 + ai * HALF + m * 16) * DM + col0 + bj * HALF);
                asm volatile("" ::: "memory");
#pragma unroll
                for (int m = 0; m < 4; ++m) {
                    const int r = row0 + ai * HALF + m * 16; const size_t off = (size_t)r * DM + col0; float q = 0.f;
#pragma unroll
                    for (int bj = 0; bj < 2; ++bj) {
                        const u32x4 bb = bv[m][bj];
                        const f32x4 b0 = (f32x4){bf_lo(bb.x), bf_hi(bb.x), bf_lo(bb.y), bf_hi(bb.y)}, b1 = (f32x4){bf_lo(bb.z), bf_hi(bb.z), bf_lo(bb.w), bf_hi(bb.w)};
                        const f32x4 o0 = b0 + acc[ai][bj][m][0] * alpha, o1 = b1 + acc[ai][bj][m][1] * alpha;
                        q += (o0[0] * o0[0] + o0[1] * o0[1]) + (o0[2] * o0[2] + o0[3] * o0[3]) + (o1[0] * o1[0] + o1[1] * o1[1]) + (o1[2] * o1[2] + o1[3] * o1[3]);
                        u32x4 w; w.x = cvt_pk_bf16(o0[0], o0[1]); w.y = cvt_pk_bf16(o0[2], o0[3]); w.z = cvt_pk_bf16(o1[0], o1[1]); w.w = cvt_pk_bf16(o1[2], o1[3]);
                        *(GAS u32x4*)(xb + off + bj * HALF) = w;
                    }
                    q += __shfl_xor(q, 16); q += __shfl_xor(q, 32); if (fq == 0) __builtin_amdgcn_global_atomic_fadd_f32(ssout + r, q);
                }
            }
        }
    }
};
struct EpiFinal {   static constexpr bool SSPRE = false;
    const GAS bf16_t* base; GAS float* out; const GAS float* gain; float* xbuf; unsigned* cnt; LAS float* red; float alpha;
    __device__ __forceinline__ void operator()(f32x4 (&acc)[2][2][4][2], const Unit& u, int wr, int wc, int fr, int fq) const {
        const int tid = threadIdx.x, lane = tid & 63, wid = tid >> 6;
        const int row0 = u.pm * BM + wr * 64 + fr, col0 = u.pn * BM + wc * 32 + 8 * fq;
        LAS float* S = red + 1024;
#pragma unroll
        for (int ai = 0; ai < 2; ++ai) {
            u32x4 bv[4][2];
#pragma unroll
            for (int m = 0; m < 4; ++m)
#pragma unroll
                for (int bj = 0; bj < 2; ++bj) bv[m][bj] = *(const GAS u32x4*)(base + (size_t)(row0 + ai * HALF + m * 16) * DM + col0 + bj * HALF);
#pragma unroll
            for (int m = 0; m < 4; ++m) {
                float q = 0.f;
#pragma unroll
                for (int bj = 0; bj < 2; ++bj) {
                    const u32x4 bb = bv[m][bj];
                    const f32x4 b0 = (f32x4){bf_lo(bb.x), bf_hi(bb.x), bf_lo(bb.y), bf_hi(bb.y)}, b1 = (f32x4){bf_lo(bb.z), bf_hi(bb.z), bf_lo(bb.w), bf_hi(bb.w)};
                    const f32x4 o0 = b0 + acc[ai][bj][m][0] * alpha, o1 = b1 + acc[ai][bj][m][1] * alpha;
                    q += (o0[0] * o0[0] + o0[1] * o0[1]) + (o0[2] * o0[2] + o0[3] * o0[3]) + (o1[0] * o1[0] + o1[1] * o1[1]) + (o1[2] * o1[2] + o1[3] * o1[3]);
                    acc[ai][bj][m][0] = o0; acc[ai][bj][m][1] = o1;
                }
                q += __shfl_xor(q, 16); q += __shfl_xor(q, 32);
                if (fq == 0) red[(ai * HALF + wr * 64 + m * 16 + fr) * 4 + wc] = q;
            }
        }
        asm volatile("s_waitcnt lgkmcnt(0)" ::: "memory"); __builtin_amdgcn_s_barrier(); asm volatile("" ::: "memory");
        if (tid < 256) {
            const f32x4 r4 = *(const LAS f32x4*)(red + tid * 4);
            __hip_atomic_store(xbuf + ((size_t)(u.pm * BM + tid) * 4 + u.pn), (r4[0] + r4[1]) + (r4[2] + r4[3]), __ATOMIC_RELAXED, __HIP_MEMORY_SCOPE_AGENT);
        }
        asm volatile("s_waitcnt vmcnt(0) lgkmcnt(0)" ::: "memory");
        if (tid < 256 && lane == 0) __hip_atomic_fetch_add(cnt + 64 * u.pm, 1u, __ATOMIC_RELAXED, __HIP_MEMORY_SCOPE_AGENT);
        if (wid == 0) {
            unsigned sp = 0;
            while ((unsigned)__builtin_amdgcn_readfirstlane(__hip_atomic_load(cnt + 64 * u.pm, __ATOMIC_RELAXED, __HIP_MEMORY_SCOPE_AGENT)) < 16u) { __builtin_amdgcn_s_sleep(2); if (++sp > (1u << 22)) break; }
            __builtin_amdgcn_fence(__ATOMIC_ACQUIRE, "agent");
        }
        asm volatile("s_waitcnt vmcnt(0) lgkmcnt(0)" ::: "memory"); __builtin_amdgcn_s_barrier(); asm volatile("" ::: "memory");
        if (tid < 256) {
            const float* slot = xbuf + (size_t)(u.pm * BM + tid) * 4;
            const float t0 = __hip_atomic_load(slot + 0, __ATOMIC_RELAXED, __HIP_MEMORY_SCOPE_AGENT), t1 = __hip_atomic_load(slot + 1, __ATOMIC_RELAXED, __HIP_MEMORY_SCOPE_AGENT),
                        t2 = __hip_atomic_load(slot + 2, __ATOMIC_RELAXED, __HIP_MEMORY_SCOPE_AGENT), t3 = __hip_atomic_load(slot + 3, __ATOMIC_RELAXED, __HIP_MEMORY_SCOPE_AGENT);
            S[tid] = rsqrtf(((t0 + t1) + (t2 + t3)) * (1.0f / 1024.0f) + EPS);
        }
        asm volatile("s_waitcnt vmcnt(0) lgkmcnt(0)" ::: "memory"); __builtin_amdgcn_s_barrier(); asm volatile("" ::: "memory");
        f32x4 gv[2][2];
#pragma unroll
        for (int bj = 0; bj < 2; ++bj) { gv[bj][0] = *(const GAS f32x4*)(gain + col0 + bj * HALF); gv[bj][1] = *(const GAS f32x4*)(gain + col0 + bj * HALF + 4); }
#pragma unroll
        for (int ai = 0; ai < 2; ++ai)
#pragma unroll
            for (int m = 0; m < 4; ++m) {
                const int rl = ai * HALF + wr * 64 + m * 16 + fr; const float sc = S[rl];
                GAS float* rowp = out + (size_t)(u.pm * BM + rl) * DM + col0;
#pragma unroll
                for (int bj = 0; bj < 2; ++bj) {
                    __builtin_nontemporal_store(acc[ai][bj][m][0] * sc * gv[bj][0], (GAS f32x4*)(rowp + bj * HALF));
                    __builtin_nontemporal_store(acc[ai][bj][m][1] * sc * gv[bj][1], (GAS f32x4*)(rowp + bj * HALF + 4));
                }
            }
    }
};
struct EpiSoftmax { static constexpr bool SSPRE = false;
    GAS bf16_t* O; LAS float* red;
    __device__ __forceinline__ void operator()(f32x4 (&acc)[2][2][4][2], const Unit& u, int wr, int wc, int fr, int fq) const {
        const int row0 = u.pm * BM + wr * 64 + fr, col0 = u.pn * BM + wc * 32 + 8 * fq;
        LAS float* red2 = red + 1024;
#pragma unroll
        for (int ai = 0; ai < 2; ++ai)
#pragma unroll
            for (int m = 0; m < 4; ++m) {
                float v = -3.0e38f;
#pragma unroll
                for (int bj = 0; bj < 2; ++bj)
#pragma unroll
                    for (int n = 0; n < 2; ++n) { const f32x4 x = acc[ai][bj][m][n]; v = fmaxf(v, fmaxf(fmaxf(x[0], x[1]), fmaxf(x[2], x[3]))); }
                v = fmaxf(v, __shfl_xor(v, 16)); v = fmaxf(v, __shfl_xor(v, 32));
                if (fq == 0) red[(ai * HALF + wr * 64 + m * 16 + fr) * 4 + wc] = v;
            }
        asm volatile("s_waitcnt lgkmcnt(0)" ::: "memory"); __builtin_amdgcn_s_barrier(); asm volatile("" ::: "memory");
#pragma unroll
        for (int ai = 0; ai < 2; ++ai)
#pragma unroll
            for (int m = 0; m < 4; ++m) {
                const int rl = ai * HALF + wr * 64 + m * 16 + fr;
                const f32x4 r4 = *(const LAS f32x4*)(red + rl * 4);
                const float mx = fmaxf(fmaxf(r4[0], r4[1]), fmaxf(r4[2], r4[3])) * LOG2E; float sum = 0.f;
#pragma unroll
                for (int bj = 0; bj < 2; ++bj)
#pragma unroll
                    for (int n = 0; n < 2; ++n) {
                        f32x4 x = acc[ai][bj][m][n];
#pragma unroll
                        for (int e = 0; e < 4; ++e) { x[e] = __builtin_amdgcn_exp2f(x[e] * LOG2E - mx); sum += x[e]; }
                        acc[ai][bj][m][n] = x;
                    }
                sum += __shfl_xor(sum, 16); sum += __shfl_xor(sum, 32);
                if (fq == 0) red2[rl * 4 + wc] = sum;
            }
        asm volatile("s_waitcnt lgkmcnt(0)" ::: "memory"); __builtin_amdgcn_s_barrier(); asm volatile("" ::: "memory");
#pragma unroll
        for (int ai = 0; ai < 2; ++ai)
#pragma unroll
            for (int m = 0; m < 4; ++m) {
                const int rl = ai * HALF + wr * 64 + m * 16 + fr; const int r = row0 + ai * HALF + m * 16;
                const f32x4 r4 = *(const LAS f32x4*)(red2 + rl * 4);
                const float inv = 1.0f / ((r4[0] + r4[1]) + (r4[2] + r4[3]));
                GAS bf16_t* rowp = O + (size_t)r * DM + col0;
#pragma unroll
                for (int bj = 0; bj < 2; ++bj) {
                    const f32x4 v0 = acc[ai][bj][m][0] * inv, v1 = acc[ai][bj][m][1] * inv;
                    u32x4 w; w.x = cvt_pk_bf16(v0[0], v0[1]); w.y = cvt_pk_bf16(v0[2], v0[3]); w.z = cvt_pk_bf16(v1[0], v1[1]); w.w = cvt_pk_bf16(v1[2], v1[3]);
                    *(GAS u32x4*)(rowp + bj * HALF) = w;
                }
            }
    }
};

template <class Epi, class Sched>
__device__ __forceinline__ void gemm_phase(LAS unsigned char* lds, const Gemm g, const Sched& S, const Epi& E) {
    int tid_ = threadIdx.x; asm volatile("" : "+v"(tid_));
    const int tid = tid_, wid = __builtin_amdgcn_readfirstlane(tid >> 6), lane = tid & 63, wr = wid >> 2, wc = wid & 3, fr = lane & 15, fq = lane >> 4;
    const int nt = g.K / BK;
    unsigned voffA[2], voffB[2];
#pragma unroll
    for (int i = 0; i < 2; ++i) { int R, C; stage_rc(tid * 16 + i * 8192, R, C); const int Rb = (R & ~31) + perm32(R & 31);
        voffA[i] = (unsigned)(R * g.lda + C) * 2u; voffB[i] = (unsigned)(Rb * g.ldb + C) * 2u; }
    const size_t kstep = (size_t)(BK * 2);
    const size_t hstepA = (size_t)HALF * g.lda * 2, hstepB = (size_t)HALF * g.ldb * 2;
    const unsigned ldsw = (unsigned)wid * 1024u;
    const int aoff = lds_byte(wr * 64 + fr, fq * 8), boff = lds_byte(wc * 32 + fr, fq * 8);
#define PG8_SA(b, h) (((b) * 2 + (h)) * HTB)
#define PG8_SB(b, h) ((4 + (b) * 2 + (h)) * HTB)
#define PG8_STAGE(bufoff, gbase, voff) do { _Pragma("unroll") for (int _i = 0; _i < 2; ++_i) \
        __builtin_amdgcn_global_load_lds((const GAS unsigned*)((gbase) + (voff)[_i]), (LAS unsigned*)(lds + (bufoff) + ldsw + _i * 8192), 16, 0, 0); } while (0)
#define PG8_LDA(dst, b, h) do { _Pragma("unroll") for (int m = 0; m < 4; ++m) _Pragma("unroll") for (int k = 0; k < 2; ++k) dst[m][k] = *(const LAS bf16x8*)(lds + PG8_SA(b, h) + aoff + m * 2048 + k * 1024); } while (0)
#define PG8_LDB(dst, b, h) do { _Pragma("unroll") for (int n = 0; n < 2; ++n) _Pragma("unroll") for (int k = 0; k < 2; ++k) dst[n][k] = *(const LAS bf16x8*)(lds + PG8_SB(b, h) + boff + n * 2048 + k * 1024); } while (0)
#define PG8_MMA(ai, bj, At, Bt) do { _Pragma("unroll") for (int m = 0; m < 4; ++m) _Pragma("unroll") for (int n = 0; n < 2; ++n) _Pragma("unroll") for (int k = 0; k < 2; ++k) \
        acc[ai][bj][m][n] = __builtin_amdgcn_mfma_f32_16x16x32_bf16(Bt[n][k], At[m][k], acc[ai][bj][m][n], 0, 0, 0); } while (0)
#define PG8_WAIT_V(n) asm volatile("s_waitcnt vmcnt(" #n ")" ::: "memory")
#define PG8_WAIT_L(n) asm volatile("s_waitcnt lgkmcnt(" #n ")" ::: "memory")
#define PG8_BAR __builtin_amdgcn_s_barrier()
#define PG8_SCHED __builtin_amdgcn_sched_barrier(0)
    Unit cur, nxt; int ui = 0;
    if (!S.next(0, cur)) return;
    f32x4 acc[2][2][4][2];
#pragma unroll
    for (int a = 0; a < 2; ++a)
#pragma unroll
        for (int b = 0; b < 2; ++b)
#pragma unroll
            for (int m = 0; m < 4; ++m)
#pragma unroll
                for (int n = 0; n < 2; ++n) acc[a][b][m][n] = (f32x4){0.f, 0.f, 0.f, 0.f};
    bf16x8 At[4][2], B0[2][2], B1[2][2];
    const GAS char* cA = cur.A; const GAS char* cB = cur.B;
    LAS float* scb = (LAS float*)(lds + 140288);
    if constexpr (Epi::SSPRE) { if (tid < 256) scb[tid] = __builtin_amdgcn_rsqf(E.ss[cur.pm * BM + tid] * (1.0f / 1024.0f) + EPS); }
    PG8_STAGE(PG8_SB(0, 0), cB, voffB); PG8_STAGE(PG8_SB(0, 1), cB + hstepB, voffB); PG8_STAGE(PG8_SA(0, 0), cA, voffA); PG8_STAGE(PG8_SA(0, 1), cA + hstepA, voffA);
    if (wr == 1) PG8_BAR;
    PG8_WAIT_V(2); PG8_BAR;
    PG8_STAGE(PG8_SB(1, 0), cB + kstep, voffB); PG8_STAGE(PG8_SB(1, 1), cB + hstepB + kstep, voffB);
    PG8_WAIT_V(6); PG8_BAR;
    for (;;) {
        const bool has_next = S.next(ui + 1, nxt);
        const GAS char* nA = has_next ? nxt.A : cA; const GAS char* nB = has_next ? nxt.B : cB;
#pragma unroll 1
        for (int t = 0; t < nt; t += 2) {
            const bool last = (t == nt - 2);
            const GAS char* a1 = cA + (size_t)(t + 1) * kstep;
            const GAS char* a2 = last ? nA : cA + (size_t)(t + 2) * kstep; const GAS char* b2 = last ? nB : cB + (size_t)(t + 2) * kstep;
            const GAS char* b3 = b2 + kstep;
            PG8_LDB(B0, 0, 0); PG8_LDB(B1, 0, 1); PG8_SCHED; PG8_LDA(At, 0, 0); PG8_STAGE(PG8_SA(1, 0), a1, voffA); PG8_STAGE(PG8_SA(1, 1), a1 + hstepA, voffA);
            PG8_WAIT_V(8); PG8_WAIT_L(0); __builtin_amdgcn_s_setprio(1); PG8_BAR; PG8_MMA(0, 0, At, B0); PG8_MMA(0, 1, At, B1); __builtin_amdgcn_s_setprio(0); PG8_BAR; PG8_SCHED;
            PG8_LDA(At, 0, 1); PG8_STAGE(PG8_SB(0, 0), b2, voffB); PG8_STAGE(PG8_SB(0, 1), b2 + hstepB, voffB);
            PG8_WAIT_V(6); PG8_WAIT_L(0); __builtin_amdgcn_s_setprio(1); PG8_BAR; PG8_MMA(1, 0, At, B0); PG8_MMA(1, 1, At, B1); __builtin_amdgcn_s_setprio(0); PG8_BAR; PG8_SCHED;
            PG8_LDB(B0, 1, 0); PG8_LDB(B1, 1, 1); PG8_SCHED; PG8_LDA(At, 1, 0); PG8_STAGE(PG8_SA(0, 0), a2, voffA); PG8_STAGE(PG8_SA(0, 1), a2 + hstepA, voffA);
            PG8_WAIT_V(8); PG8_WAIT_L(0); __builtin_amdgcn_s_setprio(1); PG8_BAR; PG8_MMA(0, 0, At, B0); PG8_MMA(0, 1, At, B1); __builtin_amdgcn_s_setprio(0); PG8_BAR; PG8_SCHED;
            PG8_LDA(At, 1, 1); PG8_STAGE(PG8_SB(1, 0), b3, voffB); PG8_STAGE(PG8_SB(1, 1), b3 + hstepB, voffB);
            PG8_WAIT_V(6); PG8_WAIT_L(0); __builtin_amdgcn_s_setprio(1); PG8_BAR; PG8_MMA(1, 0, At, B0); PG8_MMA(1, 1, At, B1); __builtin_amdgcn_s_setprio(0); PG8_BAR; PG8_SCHED;
        }
        if (wr == 0) PG8_BAR;
        if constexpr (Epi::SSPRE) {
            const bool pf = has_next && tid < 256;
            const float nv = E.ss[(has_next ? nxt.pm : cur.pm) * BM + (tid & 255)];
            E(acc, cur, wr, wc, fr, fq, scb + (ui & 1) * 256, ScNext{nv, scb + ((ui + 1) & 1) * 256 + (tid & 255), pf});
        } else E(acc, cur, wr, wc, fr, fq);
        if (!has_next) break;
#pragma unroll
        for (int a = 0; a < 2; ++a)
#pragma unroll
            for (int b = 0; b < 2; ++b)
#pragma unroll
                for (int m = 0; m < 4; ++m)
#pragma unroll
                    for (int n = 0; n < 2; ++n) acc[a][b][m][n] = (f32x4){0.f, 0.f, 0.f, 0.f};
        cur = nxt; cA = nA; cB = nB; ++ui;
        if (wr == 1) PG8_BAR;
    }
    PG8_WAIT_V(0);
    PG8_BAR;
#undef PG8_SA
#undef PG8_SB
#undef PG8_STAGE
#undef PG8_LDA
#undef PG8_LDB
#undef PG8_MMA
#undef PG8_WAIT_V
#undef PG8_WAIT_L
#undef PG8_BAR
#undef PG8_SCHED
}
}

constexpr int LDS_BYTES = 143360;
constexpr int LDS_RED_OFF = 131072;
constexpr int MIXSTR = 1032;
constexpr int LDS_PART_OFF = 128 * MIXSTR;
static_assert(LDS_PART_OFF + 4096 <= LDS_BYTES && LDS_RED_OFF + 8192 <= LDS_BYTES && 140288 + 2048 <= LDS_BYTES, "LDS map");

struct Params { const float* in[26]; float* out; unsigned char* ws; };
constexpr int LDS_PTR_OFF = 139264;
__device__ __forceinline__ GAS unsigned char* ldptr(LAS unsigned char* lds, int i) {
    const u32x2 v = *(const LAS u32x2*)(lds + LDS_PTR_OFF + 8 * i);
    const unsigned lo = __builtin_amdgcn_readfirstlane(v.x), hi = __builtin_amdgcn_readfirstlane(v.y);
    return (GAS unsigned char*)(((unsigned long long)hi << 32) | lo);
}
#define INP(k) ((const GAS float*)ldptr(lds, (k)))
#define WSP(off) (ldptr(lds, 27) + (off))
#define OUTP ((GAS float*)ldptr(lds, 26))
#ifndef PHMASK
#define PHMASK 0xFFFF
#endif
#define PH(n) if constexpr (((PHMASK) >> (n)) & 1)
#define LOCAL_SEAM() do { asm volatile("s_waitcnt vmcnt(0)" ::: "memory"); __syncthreads(); __builtin_amdgcn_fence(__ATOMIC_ACQUIRE, "agent"); asm volatile("s_waitcnt vmcnt(0)" ::: "memory"); __syncthreads(); } while (0)

__device__ __forceinline__ int rowmap(int mode, int n0) {
    if (mode == 1) { const int isu = n0 >= DFF, j = isu ? n0 - DFF : n0; return 256 * (j >> 7) + 128 * isu + (j & 127); }
    if (mode == 2) { if (n0 < 512 || n0 >= 1536) return n0; const int isx = n0 >= 1024, j = n0 - (isx ? 1024 : 512); return 512 + 256 * (j >> 7) + 128 * isx + (j & 127); }
    return n0;
}
__device__ __forceinline__ void tr_item(const GAS float* W, int K, int N, GAS bf16_t* WT, int mode, const GAS float* gain, float cst, LAS float* scr, int item, int lane) {
    const int nblk = N / 32, kb = item / nblk, nb = item % nblk, k0 = 64 * kb, n0 = 32 * nb;
#pragma unroll
    for (int i = 0; i < 32; ++i) { const int kk = 2 * i + (lane >> 5); const float gsc = gain ? gain[k0 + kk] * cst : cst;
        scr[kk * 33 + (lane & 31)] = W[(size_t)(k0 + kk) * N + n0 + (lane & 31)] * gsc; }
    asm volatile("s_waitcnt lgkmcnt(0)" ::: "memory");
    const int c = lane & 7, drow0 = rowmap(mode, n0);
#pragma unroll
    for (int j = 0; j < 4; ++j) { const int n = (lane >> 3) + 8 * j; const LAS float* s = scr + (8 * c) * 33 + n;
        u32x4 o; o.x = cvt_pk_bf16(s[0 * 33], s[1 * 33]); o.y = cvt_pk_bf16(s[2 * 33], s[3 * 33]); o.z = cvt_pk_bf16(s[4 * 33], s[5 * 33]); o.w = cvt_pk_bf16(s[6 * 33], s[7 * 33]);
        *(GAS u32x4*)(WT + (size_t)(drow0 + n) * K + k0 + 8 * c) = o; }
    asm volatile("s_waitcnt lgkmcnt(0)" ::: "memory");
}


#define XB_TMO      128
#define XB_XCNT(j)  (256  + 64 * (j))
#define XB_XSUB(j)  (1280 + 64 * (j))
#define XB_XGEN(j)  (2304 + 64 * (j))
#define XB_TOP      3328
#define XB_TOPGEN   3392
#define XCD_BAR_WORDS 3456
#define XB_SPIN_CAP (1u << 22)
__device__ __forceinline__ unsigned xb_ld(unsigned* p)              { return __hip_atomic_load(p, __ATOMIC_RELAXED, __HIP_MEMORY_SCOPE_AGENT); }
__device__ __forceinline__ unsigned xb_add(unsigned* p, unsigned v) { return __hip_atomic_fetch_add(p, v, __ATOMIC_RELAXED, __HIP_MEMORY_SCOPE_AGENT); }
__device__ __forceinline__ unsigned xb_xcc_id() { return (unsigned)__builtin_amdgcn_s_getreg((3 << 11) | 20) & 0xFu; }
#define XB_SPIN(cond, bar) do { unsigned _sp = 0; while (cond) { __builtin_amdgcn_s_sleep(1); \
    if ((++_sp & 255u) == 0u) { if (xb_ld(&(bar)[XB_TMO])) break; if (_sp > XB_SPIN_CAP) { atomicAdd(&(bar)[XB_TMO], 1u); break; } } } } while (0)
struct XcdBarrier { unsigned* bar; unsigned x; volatile LAS unsigned* st; };
__device__ __forceinline__ XcdBarrier xcd_barrier_post(unsigned* bar, volatile LAS unsigned* st) {
    XcdBarrier b; b.bar = bar; b.x = xb_xcc_id(); b.st = st;
    if (threadIdx.x == 0) (void)xb_add(&bar[XB_XCNT(b.x)], 1u);
    return b;
}
__device__ __forceinline__ void xcd_barrier_complete(unsigned* bar, unsigned x, unsigned& nloc, unsigned& nx) {
    const unsigned G = gridDim.x * gridDim.y * gridDim.z;
    unsigned sum, cnt, mine, sp = 0u;
    for (;;) {
        sum = 0u; cnt = 0u; mine = 0u;
#pragma unroll
        for (unsigned j = 0; j < 16; ++j) { const unsigned c = xb_ld(&bar[XB_XCNT(j)]); sum += c; cnt += (c > 0u) ? 1u : 0u; mine = (j == x) ? c : mine; }
        if (sum == G) break;
        __builtin_amdgcn_s_sleep(1);
        if ((++sp & 255u) == 0u) { if (xb_ld(&bar[XB_TMO])) break; if (sp > XB_SPIN_CAP) { atomicAdd(&bar[XB_TMO], 1u); break; } }
    }
    nloc = mine > 0u ? mine : 1u; nx = cnt > 0u ? cnt : 1u;
}
__device__ __forceinline__ void xcd_barrier(const XcdBarrier& b) {
    asm volatile("s_waitcnt vmcnt(0)" ::: "memory");
    __syncthreads();
    if (threadIdx.x == 0) {
        unsigned* bar = b.bar;
        __builtin_amdgcn_s_waitcnt(0);
        unsigned nloc = b.st[0], nx = b.st[1];
        if (nloc == 0u) { xcd_barrier_complete(bar, b.x, nloc, nx); b.st[0] = nloc; b.st[1] = nx; }
        const unsigned old = xb_add(&bar[XB_XSUB(b.x)], 1u);
        const unsigned gen = old / nloc;
        if (old + 1u == (gen + 1u) * nloc) {
            __builtin_amdgcn_fence(__ATOMIC_RELEASE, "agent");
            asm volatile("s_waitcnt vmcnt(0)" ::: "memory");
            const unsigned og = xb_add(&bar[XB_TOP], 1u);
            const unsigned tg = og / nx;
            if (og + 1u == (tg + 1u) * nx) xb_add(&bar[XB_TOPGEN], 1u);
            else XB_SPIN(xb_ld(&bar[XB_TOPGEN]) == tg, bar);
            __builtin_amdgcn_fence(__ATOMIC_ACQUIRE, "agent");
            xb_add(&bar[XB_XGEN(b.x)], 1u);
            asm volatile("s_waitcnt vmcnt(0)" ::: "memory");
        } else {
            XB_SPIN(xb_ld(&bar[XB_XGEN(b.x)]) == gen, bar);
            __builtin_amdgcn_fence(__ATOMIC_ACQUIRE, "agent");
            asm volatile("s_waitcnt vmcnt(0)" ::: "memory");
        }
    }
    __syncthreads();
}

__global__ void __launch_bounds__(512, 2) mega_fwd(Params p) {
    extern __shared__ __attribute__((aligned(16))) unsigned char lds_raw[];
    LAS unsigned char* lds = (LAS unsigned char*)lds_raw;
    cg::grid_group grid = cg::this_grid();
    const int tid = threadIdx.x, lane = tid & 63, wave = __builtin_amdgcn_readfirstlane(tid >> 6);
    const int G = gridDim.x, bx = blockIdx.x, vcu = (G % 8 == 0) ? (bx % 8) * (G / 8) + bx / 8 : bx;
    if (tid == 0) {
#pragma unroll
        for (int i = 0; i < 26; ++i) *(LAS unsigned long long*)(lds + LDS_PTR_OFF + 8 * i) = (unsigned long long)p.in[i];
        *(LAS unsigned long long*)(lds + LDS_PTR_OFF + 8 * 26) = (unsigned long long)p.out;
        *(LAS unsigned long long*)(lds + LDS_PTR_OFF + 8 * 27) = (unsigned long long)p.ws;
        *(LAS unsigned long long*)(lds + LDS_PTR_OFF + 256) = 0ull;
    }
    __syncthreads();
#define ss0 ((GAS float*)WSP(WS_SS))
#define ss1 (ss0 + T_TOK)
#define ss2 (ss0 + 2 * T_TOK)
#define ss3 (ss0 + 3 * T_TOK)
#define ss4 (ss0 + 4 * T_TOK)
#define Wgu1 ((GAS bf16_t*)WSP(WS_WGU1))
#define Wd1 ((GAS bf16_t*)WSP(WS_WD1))
#define Win ((GAS bf16_t*)WSP(WS_WIN))
#define Wout ((GAS bf16_t*)WSP(WS_WOUT))
#define Wq ((GAS bf16_t*)WSP(WS_WQ))
#define Wkv ((GAS bf16_t*)WSP(WS_WKV))
#define Wo ((GAS bf16_t*)WSP(WS_WO))
#define Wgu2 ((GAS bf16_t*)WSP(WS_WGU2))
#define Wd2 ((GAS bf16_t*)WSP(WS_WD2))
#define Wsb ((GAS bf16_t*)WSP(WS_WSB))
#define memn ((GAS bf16_t*)WSP(WS_MEMN))
#define Kmat ((GAS bf16_t*)WSP(WS_KMAT))
#define Vt ((GAS bf16_t*)WSP(WS_VT))
#define R1 ((GAS bf16_t*)WSP(WS_R1))
#define R2 ((GAS bf16_t*)WSP(WS_R2))
#define DO_LO ((GAS bf16_t*)OUTP)
#define DO_HI ((GAS bf16_t*)((GAS unsigned char*)OUTP + 128 * MiB))
#define HSPLIT 229
#define HTAIL (DO_LO - (size_t)HSPLIT * 256 * DFF)
#define XB0 ((GAS bf16_t*)((GAS unsigned char*)OUTP + 128 * MiB))
    if (bx == 0) { for (int i = tid; i < XCD_BAR_WORDS; i += 512) ((GAS unsigned*)WSP(WS_BAR))[i] = 0u; }
    if (bx == 1 % G) { for (int i = tid; i < 256; i += 512) ((GAS unsigned*)WSP(WS_CNT))[64 * i] = 0u; }
    PH(0) {
        LAS float* scr = (LAS float*)(lds + wave * 16384);
        const int gw = vcu * 8 + wave, NGW = G * 8;
        constexpr int I_GU = 16 * 176, I_DN = 44 * 32, I_IN = 16 * 80, I_SQ = 16 * 32, I_KV = 16 * 64;
        constexpr int NITEMS = 2 * I_GU + 2 * I_DN + I_IN + 3 * I_SQ + I_KV;
        for (int it = gw; it < NITEMS; it += NGW) {
            int r = it;
            if (r < I_GU) { tr_item(INP(5), DM, NGU, Wgu1, 1, INP(4), 1.f, scr, r, lane); continue; } r -= I_GU;
            if (r < I_GU) { tr_item(INP(23), DM, NGU, Wgu2, 1, INP(22), 1.f, scr, r, lane); continue; } r -= I_GU;
            if (r < I_DN) { tr_item(INP(6), DFF, DM, Wd1, 0, nullptr, 1.f, scr, r, lane); continue; } r -= I_DN;
            if (r < I_DN) { tr_item(INP(24), DFF, DM, Wd2, 0, nullptr, 1.f, scr, r, lane); continue; } r -= I_DN;
            if (r < I_IN) { tr_item(INP(8), DM, DIN, Win, 2, INP(7), 1.f, scr, r, lane); continue; } r -= I_IN;
            if (r < I_SQ) { tr_item(INP(16), DM, DM, Wout, 0, nullptr, 1.f, scr, r, lane); continue; } r -= I_SQ;
            if (r < I_SQ) { tr_item(INP(19), DM, DM, Wq, 0, INP(18), 0.0625f, scr, r, lane); continue; } r -= I_SQ;
            if (r < I_SQ) { tr_item(INP(21), DM, DM, Wo, 0, nullptr, 1.f, scr, r, lane); continue; } r -= I_SQ;
            tr_item(INP(20), DM, 2 * DM, Wkv, 0, nullptr, 1.f, scr, r, lane);
        }
        for (int i = (gw * 64 + lane) * 4; i < 8 * 128 * 128; i += NGW * 64 * 4) {
            const f32x4 v = *(const GAS f32x4*)(INP(10) + i); u32x2 w; w.x = cvt_pk_bf16(v[0], v[1]); w.y = cvt_pk_bf16(v[2], v[3]); *(GAS u32x2*)(Wsb + i) = w; }
        f32x4 gmem[4];
#pragma unroll
        for (int j = 0; j < 4; ++j) gmem[j] = *(const GAS f32x4*)(INP(17) + 4 * lane + 256 * j);
        for (int m = gw; m < NMEMROWS; m += NGW) {
            const GAS float* src = m < 2048 ? INP(2) + (size_t)m * DM : INP(3) + (size_t)(m - 2048) * DM;
            f32x4 v[4]; float s = 0.f;
#pragma unroll
            for (int j = 0; j < 4; ++j) { v[j] = *(const GAS f32x4*)(src + 4 * lane + 256 * j); s += (v[j][0] * v[j][0] + v[j][1] * v[j][1]) + (v[j][2] * v[j][2] + v[j][3] * v[j][3]); }
            const float sc = rsqrtf(wave_sum(s) * (1.0f / 1024.0f) + EPS);
#pragma unroll
            for (int j = 0; j < 4; ++j) { const f32x4 o = v[j] * sc * gmem[j];
                u32x2 w; w.x = cvt_pk_bf16(o[0], o[1]); w.y = cvt_pk_bf16(o[2], o[3]); *(GAS u32x2*)(memn + (size_t)m * DM + 4 * lane + 256 * j) = w; }
        }
#define XLOAD(M0_, V_) do { _Pragma("unroll") for (int u = 0; u < 4; ++u) { const int m = (M0_) + u * NGW; if (m < T_TOK) { const GAS float* src = m < T_HALF ? INP(0) + (size_t)m * DM : INP(1) + (size_t)(m - T_HALF) * DM; \
            _Pragma("unroll") for (int j = 0; j < 4; ++j) V_[u][j] = __builtin_nontemporal_load((const GAS f32x4*)(src + 4 * lane + 256 * j)); } } } while (0)
        {
            f32x4 v[4][4], vn[4][4];
            if (gw < T_TOK) XLOAD(gw, v);
#pragma unroll 1
            for (int m0 = gw; m0 < T_TOK; m0 += 4 * NGW) {
                if (m0 + 4 * NGW < T_TOK) XLOAD(m0 + 4 * NGW, vn);
#pragma unroll
                for (int u = 0; u < 4; ++u) { const int m = m0 + u * NGW; if (m < T_TOK) { float sq = 0.f;
#pragma unroll
                    for (int j = 0; j < 4; ++j) { sq += (v[u][j][0] * v[u][j][0] + v[u][j][1] * v[u][j][1]) + (v[u][j][2] * v[u][j][2] + v[u][j][3] * v[u][j][3]);
                        u32x2 w; w.x = cvt_pk_bf16(v[u][j][0], v[u][j][1]); w.y = cvt_pk_bf16(v[u][j][2], v[u][j][3]); *(GAS u32x2*)(XB0 + (size_t)m * DM + 4 * lane + 256 * j) = w; }
                    sq = wave_sum(sq);
                    if (lane == 0) { ss0[m] = sq; ss1[m] = 0.f; ss2[m] = 0.f; ss3[m] = 0.f; ss4[m] = 0.f; } } }
#pragma unroll
                for (int u = 0; u < 4; ++u)
#pragma unroll
                    for (int j = 0; j < 4; ++j) v[u][j] = vn[u][j];
            }
        }
#undef XLOAD
    }
    grid.sync();
    XcdBarrier xbar = xcd_barrier_post((unsigned*)WSP(WS_BAR), (volatile LAS unsigned*)(lds + LDS_PTR_OFF + 256));

    const unsigned T1K = 256u * 1024u * 2u;
    PH(1) {
        pg8::Gemm g{1024, 1024, 1024};
        { pg8::Order S; S.init(10, 4, G, bx, 0, memn, T1K, 0, Wkv, T1K, 0); pg8::EpiPlain<false> E{Kmat, 1024, nullptr}; pg8::gemm_phase(lds, g, S, E); }
        { pg8::Order S; S.init(4, 10, G, (bx + G / 2) % G, 0, Wkv + (size_t)1024 * 1024, T1K, 0, memn, T1K, 0); pg8::EpiPlain<false> E{Vt, NMEMROWS, nullptr}; pg8::gemm_phase(lds, g, S, E); }
    }
    PH(2) {
        { pg8::Gemm g{1024, 1024, 1024}; pg8::Order S; S.init(256, 22, G, bx, 0, XB0, T1K, 0, Wgu1, T1K, 0);
          pg8::EpiGU E{R2, HTAIL, HSPLIT, ss0}; pg8::gemm_phase(lds, g, S, E); }
        xcd_barrier(xbar);
        { pg8::Gemm g{DFF, DFF, DFF}; pg8::Order S; S.init(256, 4, G, bx, 0, R2, 256u * DFF * 2u, 0, Wd1, 256u * DFF * 2u, 0); S.A2 = (const GAS char*)HTAIL; S.pmsplit = HSPLIT;
          pg8::EpiRes<true> E{INP(0), INP(1) - (size_t)T_HALF * DM, R1, ss1, 0.5f}; pg8::gemm_phase(lds, g, S, E); }
        xcd_barrier(xbar);
    }
    PH(3) { pg8::Gemm g{1024, 1024, 1024}; pg8::Order S; S.init(256, 10, G, bx, 0, R1, T1K, 0, Win, T1K, 0);
      pg8::EpiWin E{R2, ss1}; pg8::gemm_phase(lds, g, S, E); }
    xcd_barrier(xbar);
    PH(4) {
        const GAS bf16_t* MIX = R2; GAS bf16_t* YM = DO_LO;
        const GAS float* convw = INP(9); const GAS float* b_s = INP(11); const GAS float* ln_g = INP(12); const GAS float* ln_b = INP(13); const GAS float* g_co = INP(14); const GAS float* g_go = INP(15);
        LAS float* part = (LAS float*)(lds + LDS_PART_OFF);
        const int fr = lane & 15, fq = lane >> 4, h = wave, c8 = lane * 8;
        f32x4 ggo[4];
#pragma unroll
        for (int db = 0; db < 4; ++db) ggo[db] = *(const GAS f32x4*)(g_go + h * 64 + 16 * fq + 4 * db);
#define MIX_LOAD(T0_, I0_, GV_, CX_) do { const int tq_ = (T0_) + wave * 16 + (I0_); const int sm_ = (T0_) < T_HALF ? 4095 : 16383; \
            _Pragma("unroll") for (int u = 0; u < 4; ++u) { const GAS bf16_t* row = MIX + (size_t)(tq_ + u) * 2048; GV_[u] = *(const GAS u32x4*)(row + 1536 + c8); } \
            _Pragma("unroll") for (int j = 0; j < 6; ++j) { const int tt = tq_ - 1 + j; const bool ok = (tt & ~sm_) == ((T0_) & ~sm_); \
                const u32x4 ld = *(const GAS u32x4*)(MIX + (size_t)(ok ? tt : tq_) * 2048 + 512 + c8); \
                CX_[j].x = ok ? ld.x : 0u; CX_[j].y = ok ? ld.y : 0u; CX_[j].z = ok ? ld.z : 0u; CX_[j].w = ok ? ld.w : 0u; } } while (0)
        for (int ci = vcu; ci < T_TOK / 128; ci += G) {
            const int ch = (G == 256) ? 64 * ((ci & 255) >> 5) + (ci & 31) + (ci < 256 ? 32 : 0) : ci;
            const int t0 = ch * 128;
            u32x4 gvv[4], cxv[6];
            MIX_LOAD(t0, 0, gvv, cxv);
#pragma unroll 1
            for (int i0 = 0; i0 < 16; i0 += 4) {
                const int q0 = wave * 16 + i0, tq = t0 + q0;
                u32x4 gvn[4], bgv[4], cxn[6];
                if (i0 < 12) MIX_LOAD(t0, i0 + 4, gvn, cxn);
#pragma unroll
                for (int u = 0; u < 4; ++u) bgv[u] = *(const GAS u32x4*)(MIX + (size_t)(tq + u) * 2048 + c8);
                float lg[8], lb[8];
#pragma unroll
                for (int e = 0; e < 8; ++e) { lg[e] = ln_g[c8 + e]; lb[e] = ln_b[c8 + e]; }
#pragma unroll
                for (int u = 0; u < 4; ++u) {
                    const u32x4 gv = gvv[u];
                    float v[8] = {bf_lo(gv.x), bf_hi(gv.x), bf_lo(gv.y), bf_hi(gv.y), bf_lo(gv.z), bf_hi(gv.z), bf_lo(gv.w), bf_hi(gv.w)};
                    float sm = 0.f;
#pragma unroll
                    for (int e = 0; e < 8; ++e) sm += v[e];
                    const float mean = wave_sum(sm) * (1.0f / 512.0f); float s2 = 0.f;
#pragma unroll
                    for (int e = 0; e < 8; ++e) { v[e] -= mean; s2 += v[e] * v[e]; }
                    const float rstd = rsqrtf(wave_sum(s2) * (1.0f / 512.0f) + EPS);
                    u32x2 w0, w1;
                    w0.x = cvt_pk_bf16(v[0] * rstd * lg[0] + lb[0], v[1] * rstd * lg[1] + lb[1]); w0.y = cvt_pk_bf16(v[2] * rstd * lg[2] + lb[2], v[3] * rstd * lg[3] + lb[3]);
                    w1.x = cvt_pk_bf16(v[4] * rstd * lg[4] + lb[4], v[5] * rstd * lg[5] + lb[5]); w1.y = cvt_pk_bf16(v[6] * rstd * lg[6] + lb[6], v[7] * rstd * lg[7] + lb[7]);
                    *(LAS u32x2*)(lds + (q0 + u) * MIXSTR + lane * 16) = w0; *(LAS u32x2*)(lds + (q0 + u) * MIXSTR + lane * 16 + 8) = w1;
                }
                asm volatile("" ::: "memory");
                float gc[8], cw0[8], cw1[8], cw2[8];
#pragma unroll
                for (int e = 0; e < 8; ++e) { gc[e] = g_co[c8 + e]; cw0[e] = convw[c8 + e]; cw1[e] = convw[512 + c8 + e]; cw2[e] = convw[1024 + c8 + e]; }
#pragma unroll
                for (int u = 0; u < 4; ++u) {
                    const u32x4 bg = bgv[u], cx0 = cxv[u], cx1 = cxv[u + 1], cx2 = cxv[u + 2];
                    const float B[8] = {bf_lo(bg.x), bf_hi(bg.x), bf_lo(bg.y), bf_hi(bg.y), bf_lo(bg.z), bf_hi(bg.z), bf_lo(bg.w), bf_hi(bg.w)};
                    const float X0[8] = {bf_lo(cx0.x), bf_hi(cx0.x), bf_lo(cx0.y), bf_hi(cx0.y), bf_lo(cx0.z), bf_hi(cx0.z), bf_lo(cx0.w), bf_hi(cx0.w)};
                    const float X1[8] = {bf_lo(cx1.x), bf_hi(cx1.x), bf_lo(cx1.y), bf_hi(cx1.y), bf_lo(cx1.z), bf_hi(cx1.z), bf_lo(cx1.w), bf_hi(cx1.w)};
                    const float X2[8] = {bf_lo(cx2.x), bf_hi(cx2.x), bf_lo(cx2.y), bf_hi(cx2.y), bf_lo(cx2.z), bf_hi(cx2.z), bf_lo(cx2.w), bf_hi(cx2.w)};
                    float y[8]; float sq = 0.f;
#pragma unroll
                    for (int e = 0; e < 8; ++e) { y[e] = B[e] * (cw0[e] * X0[e] + cw1[e] * X1[e] + cw2[e] * X2[e]); sq += y[e] * y[e]; }
                    const float sc = rsqrtf(wave_sum(sq) * (1.0f / 512.0f) + EPS);
                    u32x4 w; w.x = cvt_pk_bf16(y[0] * sc * gc[0], y[1] * sc * gc[1]); w.y = cvt_pk_bf16(y[2] * sc * gc[2], y[3] * sc * gc[3]);
                    w.z = cvt_pk_bf16(y[4] * sc * gc[4], y[5] * sc * gc[5]); w.w = cvt_pk_bf16(y[6] * sc * gc[6], y[7] * sc * gc[7]);
                    *(GAS u32x4*)(YM + (size_t)(tq + u) * DM + c8) = w;
                }
#pragma unroll
                for (int u = 0; u < 4; ++u) gvv[u] = gvn[u];
#pragma unroll
                for (int j = 0; j < 6; ++j) cxv[j] = cxn[j];
            }
            __syncthreads();
#pragma unroll 1
            for (int ph = 0; ph < 2; ++ph) {
                f32x4 acc[4][4]; u32x4 guv[4][2];
#pragma unroll
                for (int pb = 0; pb < 4; ++pb) {
#pragma unroll
                    for (int db = 0; db < 4; ++db) acc[pb][db] = (f32x4){0.f, 0.f, 0.f, 0.f};
                    const GAS bf16_t* gup = MIX + (size_t)(t0 + ph * 64 + pb * 16 + fr) * 2048 + 1024 + h * 64 + 16 * fq;
                    guv[pb][0] = *(const GAS u32x4*)gup; guv[pb][1] = *(const GAS u32x4*)(gup + 8);
                }
#pragma unroll
                for (int ks = 0; ks < 4; ++ks) {
                    bf16x8 vf[4];
#pragma unroll
                    for (int db = 0; db < 4; ++db)
#pragma unroll
                        for (int e = 0; e < 8; ++e) vf[db][e] = *(const LAS short*)(lds + (ks * 32 + fq * 8 + e) * MIXSTR + (h * 64 + 16 * (fr >> 2) + 4 * db + (fr & 3)) * 2);
#pragma unroll
                    for (int pb = 0; pb < 4; ++pb) {
                        const bf16x8 wf = *(const GAS bf16x8*)(Wsb + (size_t)(h * 128 + ph * 64 + pb * 16 + fr) * 128 + ks * 32 + fq * 8);
#pragma unroll
                        for (int db = 0; db < 4; ++db) acc[pb][db] = __builtin_amdgcn_mfma_f32_16x16x32_bf16(vf[db], wf, acc[pb][db], 0, 0, 0);
                    }
                }
#pragma unroll
                for (int pb = 0; pb < 4; ++pb) {
                    const int prow = ph * 64 + pb * 16 + fr; const float bsv = b_s[h * 128 + prow]; float q = 0.f;
#pragma unroll
                    for (int db = 0; db < 4; ++db) {
                        const u32x4 g4 = guv[pb][db >> 1]; const unsigned gx = (db & 1) ? g4.z : g4.x, gy = (db & 1) ? g4.w : g4.y;
                        f32x4 a = acc[pb][db];
                        a[0] = bf_lo(gx) * (a[0] + bsv); a[1] = bf_hi(gx) * (a[1] + bsv); a[2] = bf_lo(gy) * (a[2] + bsv); a[3] = bf_hi(gy) * (a[3] + bsv);
                        q += (a[0] * a[0] + a[1] * a[1]) + (a[2] * a[2] + a[3] * a[3]);
                        acc[pb][db] = a;
                    }
                    q += __shfl_xor(q, 16); q += __shfl_xor(q, 32);
                    if (fq == 0) part[prow * 8 + h] = q;
                }
                __syncthreads();
#pragma unroll
                for (int pb = 0; pb < 4; ++pb) {
                    const int prow = ph * 64 + pb * 16 + fr;
                    const f32x4 p0 = *(const LAS f32x4*)(part + prow * 8), p1 = *(const LAS f32x4*)(part + prow * 8 + 4);
                    const float sc = rsqrtf(((p0[0] + p0[1]) + (p0[2] + p0[3]) + (p1[0] + p1[1]) + (p1[2] + p1[3])) * (1.0f / 512.0f) + EPS);
                    GAS bf16_t* orow = YM + (size_t)(t0 + prow) * DM + 512 + h * 64 + 16 * fq;
                    unsigned ow[8];
#pragma unroll
                    for (int db = 0; db < 4; ++db) {
                        const f32x4 o = acc[pb][db] * sc * ggo[db];
                        ow[2 * db] = cvt_pk_bf16(o[0], o[1]); ow[2 * db + 1] = cvt_pk_bf16(o[2], o[3]);
                    }
                    *(GAS u32x4*)orow = (u32x4){ow[0], ow[1], ow[2], ow[3]}; *(GAS u32x4*)(orow + 8) = (u32x4){ow[4], ow[5], ow[6], ow[7]};
                }
            }
            __syncthreads();
        }
    }
    xcd_barrier(xbar);
    PH(5) { pg8::Gemm g{1024, 1024, 1024}; pg8::Order S; S.init(256, 4, G, bx, 0, DO_LO, T1K, 0, Wout, T1K, 0);
      pg8::EpiRes<false> E{R1, R1, R1, ss2, 1.0f}; pg8::gemm_phase(lds, g, S, E); }
    xcd_barrier(xbar);
    PH(6) { pg8::Gemm g{1024, 1024, 1024}; pg8::Order S; S.init(256, 4, G, bx, 0, R1, T1K, 0, Wq, T1K, 0);
      pg8::EpiPlain<true> E{DO_HI, 1024, ss2}; pg8::gemm_phase(lds, g, S, E); }
    LOCAL_SEAM();
    PH(7) { pg8::Gemm g{1024, 1024, 256}; pg8::Order S; S.init(256, 4, G, bx, 0, DO_HI, T1K, 512, Kmat, 512, T1K);
      pg8::EpiSoftmax E{R2, (LAS float*)(lds + LDS_RED_OFF)}; pg8::gemm_phase(lds, g, S, E); }
    LOCAL_SEAM();
    PH(8) { pg8::Gemm g{1024, NMEMROWS, 256}; pg8::Order S; S.init(256, 4, G, bx, 0, R2, T1K, 512, Vt, 256u * NMEMROWS * 2u, 512);
      pg8::EpiPlain<false> E{DO_LO, 1024, nullptr}; pg8::gemm_phase(lds, g, S, E); }
    xcd_barrier(xbar);
    PH(9) { pg8::Gemm g{1024, 1024, 1024}; pg8::Order S; S.init(256, 4, G, bx, 0, DO_LO, T1K, 0, Wo, T1K, 0);
      pg8::EpiRes<false> E{R1, R1, R1, ss3, 1.0f}; pg8::gemm_phase(lds, g, S, E); }
    xcd_barrier(xbar);
    {
        GAS bf16_t* H2T = (GAS bf16_t*)WSP(WS_H2TAIL) - (size_t)HSPLIT * 256 * DFF;
        PH(10) {
            { pg8::Gemm g{1024, 1024, 1024}; pg8::Order S; S.init(256, 22, G, bx, 0, R1, T1K, 0, Wgu2, T1K, 0);
              pg8::EpiGU E{R2, H2T, HSPLIT, ss3}; pg8::gemm_phase(lds, g, S, E); }
            xcd_barrier(xbar);
        }
        if (G == 256) {
            PH(10) { pg8::Gemm g{DFF, DFF, DFF}; pg8::Order S; S.init(256, 4, G, bx, 0, R2, 256u * DFF * 2u, 0, Wd2, 256u * DFF * 2u, 0); S.A2 = (const GAS char*)H2T; S.pmsplit = HSPLIT;
              pg8::EpiFinal E{R1, OUTP, INP(25), (float*)WSP(WS_XBUF), (unsigned*)WSP(WS_CNT), (LAS float*)(lds + LDS_RED_OFF), 0.5f}; pg8::gemm_phase(lds, g, S, E); }
        } else {
            PH(10) { pg8::Gemm g{DFF, DFF, DFF}; pg8::Order S; S.init(256, 4, G, bx, 0, R2, 256u * DFF * 2u, 0, Wd2, 256u * DFF * 2u, 0); S.A2 = (const GAS char*)H2T; S.pmsplit = HSPLIT;
              pg8::EpiRes<false> E{R1, R1, R1, ss4, 0.5f}; pg8::gemm_phase(lds, g, S, E); }
            xcd_barrier(xbar);
            PH(11) {
                const int gw = vcu * 8 + wave, NGW = G * 8; const GAS float* gf = INP(25); const GAS bf16_t* X4 = R1; GAS float* xo = OUTP; const GAS float* s4 = ss4;
                for (int m = gw; m < T_TOK; m += NGW) {
                    const float sc = rsqrtf(s4[m] * (1.0f / 1024.0f) + EPS);
#pragma unroll
                    for (int j = 0; j < 2; ++j) { const int c = 8 * lane + 512 * j; const u32x4 xb = *(const GAS u32x4*)(X4 + (size_t)m * DM + c);
                        const f32x4 g0 = *(const GAS f32x4*)(gf + c), g1 = *(const GAS f32x4*)(gf + c + 4);
                        *(GAS f32x4*)(xo + (size_t)m * DM + c) = (f32x4){bf_lo(xb.x), bf_hi(xb.x), bf_lo(xb.y), bf_hi(xb.y)} * sc * g0;
                        *(GAS f32x4*)(xo + (size_t)m * DM + c + 4) = (f32x4){bf_lo(xb.z), bf_hi(xb.z), bf_lo(xb.w), bf_hi(xb.w)} * sc * g1; }
                }
            }
        }
    }
}

extern "C" void kernel_launch(void* const* d_in, const int* in_sizes, int n_in, void* d_out, int out_size, void* d_ws, size_t ws_size, hipStream_t stream) {
    static int grid_blocks = 0;
    if (grid_blocks == 0) {
        if (n_in != 26 || ws_size < WS_END) { fprintf(stderr, "kernel_launch: unexpected n_in %d / ws_size %zu\n", n_in, ws_size); grid_blocks = -1; return; }
        int dev = 0, cus = 0, per_cu = 0;
        hipGetDevice(&dev);
        hipDeviceGetAttribute(&cus, hipDeviceAttributeMultiprocessorCount, dev);
        if (hipFuncSetAttribute((const void*)mega_fwd, hipFuncAttributeMaxDynamicSharedMemorySize, LDS_BYTES) != hipSuccess) { fprintf(stderr, "kernel_launch: hipFuncSetAttribute failed\n"); grid_blocks = -1; return; }
        if (hipOccupancyMaxActiveBlocksPerMultiprocessor(&per_cu, (const void*)mega_fwd, 512, LDS_BYTES) != hipSuccess || per_cu < 1) { fprintf(stderr, "kernel_launch: occupancy query gives %d\n", per_cu); per_cu = 1; }
        (void)hipGetLastError();
        grid_blocks = cus * 1;
    }
    if (grid_blocks < 0) return;
    Params p{};
    for (int i = 0; i < 26; ++i) p.in[i] = (const float*)d_in[i];
    p.out = (float*)d_out; p.ws = (unsigned char*)d_ws;
    void* args[] = {&p};
    hipError_t e = hipLaunchCooperativeKernel((const void*)mega_fwd, dim3(grid_blocks), dim3(512), args, LDS_BYTES, stream);
    if (e != hipSuccess) fprintf(stderr, "cooperative launch failed: %s (grid %d)\n", hipGetErrorString(e), grid_blocks);
}
```

```cpp
#include <hip/hip_runtime.h>
#include <hip/hip_cooperative_groups.h>
#include <cstdio>
#include <cstdint>
namespace cg = cooperative_groups;

#define LAS __attribute__((address_space(3)))
#define GAS __attribute__((address_space(1)))
typedef unsigned short bf16_t;
typedef short bf16x8 __attribute__((ext_vector_type(8)));
typedef float f32x4 __attribute__((ext_vector_type(4)));
typedef unsigned u32x4 __attribute__((ext_vector_type(4)));
typedef unsigned u32x2 __attribute__((ext_vector_type(2)));

constexpr int T_TOK = 65536, T_HALF = 32768, DM = 1024, DFF = 2816, NGU = 5632, DIN = 2560, NMEMROWS = 2560;
constexpr float EPS = 1e-6f;
constexpr float LOG2E = 1.4426950408889634f;

constexpr size_t MiB = 1u << 20;
constexpr size_t WS_SS = 0;
constexpr size_t WS_BAR = 1536 * 1024;
constexpr size_t WS_WGU1 = 2 * MiB;
constexpr size_t WS_WD1 = 13 * MiB;
constexpr size_t WS_WIN = 19 * MiB;
constexpr size_t WS_WOUT = 24 * MiB;
constexpr size_t WS_WQ = 26 * MiB;
constexpr size_t WS_WKV = 28 * MiB;
constexpr size_t WS_WO = 32 * MiB;
constexpr size_t WS_WSB = 34 * MiB;
constexpr size_t WS_MEMN = 35 * MiB;
constexpr size_t WS_KMAT = 40 * MiB;
constexpr size_t WS_VT = 45 * MiB;
constexpr size_t WS_WGU2 = 51 * MiB;
constexpr size_t WS_WD2 = 62 * MiB;
constexpr size_t WS_H2TAIL = 2 * MiB;
constexpr size_t WS_XBUF = 40 * MiB;
constexpr size_t WS_CNT = 1280 * 1024;
constexpr size_t WS_R1 = 68 * MiB;
constexpr size_t WS_R2 = 196 * MiB;
constexpr size_t WS_END = 512 * MiB;

__device__ __forceinline__ unsigned cvt_pk_bf16(float lo, float hi) { unsigned r; asm("v_cvt_pk_bf16_f32 %0, %1, %2" : "=v"(r) : "v"(lo), "v"(hi)); return r; }
__device__ __forceinline__ float bf_lo(unsigned u) { return __uint_as_float(u << 16); }
__device__ __forceinline__ float bf_hi(unsigned u) { return __uint_as_float(u & 0xffff0000u); }
__device__ __forceinline__ float wave_sum(float v) {
#pragma unroll
    for (int o = 1; o < 64; o <<= 1) v += __shfl_xor(v, o);
    return v;
}
__device__ __forceinline__ float fast_sigmoid_mul(float x, float z) {
    return x * __builtin_amdgcn_rcpf(1.0f + __builtin_amdgcn_exp2f(-z * LOG2E));
}
typedef float f32x2 __attribute__((ext_vector_type(2)));
__device__ __forceinline__ f32x2 sigmoid_mul_pk(f32x2 x, f32x2 z) {
    const f32x2 t = z * (-LOG2E); f32x2 e; e.x = __builtin_amdgcn_exp2f(t.x); e.y = __builtin_amdgcn_exp2f(t.y);
    const f32x2 d = e + 1.0f; f32x2 r; r.x = __builtin_amdgcn_rcpf(d.x); r.y = __builtin_amdgcn_rcpf(d.y);
    return x * r;
}
__device__ __forceinline__ f32x2 gelu_tanh_pk(f32x2 x) { return sigmoid_mul_pk(x, (x * x * 0.044715f + 1.0f) * x * 1.5957691216057308f); }
__device__ __forceinline__ float gelu_tanh(float x) { return fast_sigmoid_mul(x, 1.5957691216057308f * (x + 0.044715f * x * x * x)); }
__device__ __forceinline__ float silu(float x) { return fast_sigmoid_mul(x, x); }

namespace pg8 {
constexpr int BM = 256, BK = 64, HALF = 128, HTB = HALF * BK * 2, STAGE_BYTES = 8 * HTB, NXCD = 8, WGM = 8;

__host__ __device__ __forceinline__ int lds_byte(int r, int c) { const int st = (r >> 4) * 2 + (c >> 5), rr = r & 15, cc = c & 31, ob = rr * 64 + cc * 2; return st * 1024 + (ob ^ (((ob >> 9) & 1) << 5)); }
__host__ __device__ __forceinline__ void stage_rc(int b, int& R, int& C) { const int st = b / 1024, sb = b % 1024, swz = sb ^ (((sb >> 9) & 1) << 5); R = (st >> 1) * 16 + swz / 64; C = (st & 1) * 32 + (swz % 64) / 2; }
__host__ __device__ __forceinline__ int perm32(int rho) { const int n = rho >> 4, i = rho & 15; return 8 * (i >> 2) + 4 * n + (i & 3); }

struct Unit { int pm, pn; const GAS char* A; const GAS char* B; };
struct Gemm { int lda, ldb, K; };

struct Order {
    int nM, nN, nwg, G, c, pm0;
    const GAS char* A; const GAS char* A2; const GAS char* B; unsigned tA, cA, tB, bB; int pmsplit;
    __device__ __forceinline__ void init(int nM_, int nN_, int G_, int c_, int pm0_, const GAS void* A_, unsigned tA_, unsigned cA_, const GAS void* B_, unsigned tB_, unsigned bB_) {
        nM = nM_; nN = nN_; nwg = nM_ * nN_; G = G_; c = c_; pm0 = pm0_; A = (const GAS char*)A_; A2 = A; pmsplit = 1 << 30; B = (const GAS char*)B_; tA = tA_; cA = cA_; tB = tB_; bB = bB_;
    }
    __device__ __forceinline__ bool next(int i, Unit& u) const {
        const long L = (long)i * G + c; if (L >= nwg) return false;
        int wgid = (int)L; { const int q = nwg / NXCD, r = nwg % NXCD, xcd = wgid % NXCD, off = wgid / NXCD; wgid = (xcd < r ? xcd * (q + 1) : r * (q + 1) + (xcd - r) * q) + off; }
        const int nig = WGM * nN, gid = wgid / nig, fm = gid * WGM, gsz = (nM - fm) < WGM ? (nM - fm) : WGM;
        u.pm = pm0 + fm + ((wgid % nig) % gsz); u.pn = (wgid % nig) / gsz;
        const int b = u.pm < 128 ? (u.pm >> 4) : 8 + ((u.pm - 128) >> 6);
        u.A = (u.pm < pmsplit ? A : A2) + (size_t)u.pm * tA + (size_t)u.pn * cA;
        u.B = B + (size_t)u.pn * tB + (size_t)b * bB;
        return true;
    }
};

struct ScNext { float nv; LAS float* dst; bool pf; };
template <bool SS> struct EpiPlain {
    static constexpr bool SSPRE = SS;
    GAS bf16_t* O; int ldc; const GAS float* ss;
    __device__ __forceinline__ void operator()(f32x4 (&acc)[2][2][4][2], const Unit& u, int wr, int wc, int fr, int fq, const LAS float* sc = nullptr, const ScNext nx = ScNext{0.f, nullptr, false}) const {
        const int row0 = u.pm * BM + wr * 64 + fr, col0 = u.pn * BM + wc * 32 + 8 * fq;
        float rs_[2][4];
#pragma unroll
        for (int ai = 0; ai < 2; ++ai)
#pragma unroll
            for (int m = 0; m < 4; ++m) rs_[ai][m] = SS ? sc[ai * HALF + wr * 64 + m * 16 + fr] : 1.0f;
#pragma unroll
        for (int ai = 0; ai < 2; ++ai)
#pragma unroll
            for (int m = 0; m < 4; ++m) {
                if (ai == 1 && m == 0) { if (nx.pf) *nx.dst = __builtin_amdgcn_rsqf(nx.nv * (1.0f / 1024.0f) + EPS); }
                const int r = row0 + ai * HALF + m * 16; const float s = rs_[ai][m];
                GAS bf16_t* rowp = O + (size_t)r * ldc + col0;
#pragma unroll
                for (int bj = 0; bj < 2; ++bj) {
                    const f32x4 v0 = acc[ai][bj][m][0] * s, v1 = acc[ai][bj][m][1] * s;
                    u32x4 w; w.x = cvt_pk_bf16(v0[0], v0[1]); w.y = cvt_pk_bf16(v0[2], v0[3]); w.z = cvt_pk_bf16(v1[0], v1[1]); w.w = cvt_pk_bf16(v1[2], v1[3]);
                    *(GAS u32x4*)(rowp + bj * HALF) = w;
                }
            }
    }
};
struct EpiGU {      static constexpr bool SSPRE = true;
    GAS bf16_t* Hh; GAS bf16_t* Hh2; int pmsplit; const GAS float* ss;
    __device__ __forceinline__ void operator()(f32x4 (&acc)[2][2][4][2], const Unit& u, int wr, int wc, int fr, int fq, const LAS float* sc, const ScNext nx) const {
        const int row0 = u.pm * BM + wr * 64 + fr, col0 = u.pn * HALF + wc * 32 + 8 * fq;
        GAS bf16_t* Hb = u.pm < pmsplit ? Hh : Hh2;
        float rs_[2][4];
#pragma unroll
        for (int ai = 0; ai < 2; ++ai)
#pragma unroll
            for (int m = 0; m < 4; ++m) rs_[ai][m] = sc[ai * HALF + wr * 64 + m * 16 + fr];
#pragma unroll
        for (int ai = 0; ai < 2; ++ai)
#pragma unroll
            for (int m = 0; m < 4; ++m) {
                if (ai == 1 && m == 0) { if (nx.pf) *nx.dst = __builtin_amdgcn_rsqf(nx.nv * (1.0f / 1024.0f) + EPS); }
                const int r = row0 + ai * HALF + m * 16; const float s = rs_[ai][m];
                f32x2 o[4];
#pragma unroll
                for (int n = 0; n < 2; ++n)
#pragma unroll
                    for (int h2 = 0; h2 < 2; ++h2) { const f32x4 ga = acc[ai][0][m][n], ua = acc[ai][1][m][n];
                        const f32x2 g = (f32x2){ga[2 * h2], ga[2 * h2 + 1]} * s, uu = (f32x2){ua[2 * h2], ua[2 * h2 + 1]} * s; o[n * 2 + h2] = sigmoid_mul_pk(g, g) * uu; }
                u32x4 w; w.x = cvt_pk_bf16(o[0].x, o[0].y); w.y = cvt_pk_bf16(o[1].x, o[1].y); w.z = cvt_pk_bf16(o[2].x, o[2].y); w.w = cvt_pk_bf16(o[3].x, o[3].y);
                __builtin_nontemporal_store(w, (GAS u32x4*)(Hb + (size_t)r * DFF + col0));
            }
    }
};
struct EpiWin {     static constexpr bool SSPRE = true;
    GAS bf16_t* O; const GAS float* ss;
    __device__ __forceinline__ void operator()(f32x4 (&acc)[2][2][4][2], const Unit& u, int wr, int wc, int fr, int fq, const LAS float* sc, const ScNext nx) const {
        const int row0 = u.pm * BM + wr * 64 + fr, cw = wc * 32 + 8 * fq, pn = u.pn;
        float rs_[2][4];
#pragma unroll
        for (int ai = 0; ai < 2; ++ai)
#pragma unroll
            for (int m = 0; m < 4; ++m) rs_[ai][m] = sc[ai * HALF + wr * 64 + m * 16 + fr];
#pragma unroll
        for (int ai = 0; ai < 2; ++ai)
#pragma unroll
            for (int m = 0; m < 4; ++m) {
                if (ai == 1 && m == 0) { if (nx.pf) *nx.dst = __builtin_amdgcn_rsqf(nx.nv * (1.0f / 1024.0f) + EPS); }
                const int r = row0 + ai * HALF + m * 16; const float s = rs_[ai][m];
                GAS bf16_t* rowp = O + (size_t)r * 2048;
                if (pn < 2) {
#pragma unroll
                    for (int bj = 0; bj < 2; ++bj) {
                        const f32x4 v0 = acc[ai][bj][m][0] * s, v1 = acc[ai][bj][m][1] * s;
                        u32x4 w; w.x = cvt_pk_bf16(v0[0], v0[1]); w.y = cvt_pk_bf16(v0[2], v0[3]); w.z = cvt_pk_bf16(v1[0], v1[1]); w.w = cvt_pk_bf16(v1[2], v1[3]);
                        __builtin_nontemporal_store(w, (GAS u32x4*)(rowp + pn * 256 + bj * HALF + cw));
                    }
                } else if (pn < 6) {
                    const f32x4 v0 = (acc[ai][0][m][0] * s) * (acc[ai][1][m][0] * s), v1 = (acc[ai][0][m][1] * s) * (acc[ai][1][m][1] * s);
                    u32x4 w; w.x = cvt_pk_bf16(v0[0], v0[1]); w.y = cvt_pk_bf16(v0[2], v0[3]); w.z = cvt_pk_bf16(v1[0], v1[1]); w.w = cvt_pk_bf16(v1[2], v1[3]);
                    __builtin_nontemporal_store(w, (GAS u32x4*)(rowp + 512 + (pn - 2) * HALF + cw));
                } else {
#pragma unroll
                    for (int bj = 0; bj < 2; ++bj) {
                        f32x2 o[4];
#pragma unroll
                        for (int n = 0; n < 2; ++n)
#pragma unroll
                            for (int h2 = 0; h2 < 2; ++h2) { const f32x4 xa = acc[ai][bj][m][n]; o[n * 2 + h2] = gelu_tanh_pk((f32x2){xa[2 * h2], xa[2 * h2 + 1]} * s); }
                        u32x4 w; w.x = cvt_pk_bf16(o[0].x, o[0].y); w.y = cvt_pk_bf16(o[1].x, o[1].y); w.z = cvt_pk_bf16(o[2].x, o[2].y); w.w = cvt_pk_bf16(o[3].x, o[3].y);
                        __builtin_nontemporal_store(w, (GAS u32x4*)(rowp + 1024 + (pn - 6) * 256 + bj * HALF + cw));
                    }
                }
            }
    }
};
template <bool BASE_F32> struct EpiRes {   static constexpr bool SSPRE = false;
    const GAS void* base; const GAS void* base2; GAS bf16_t* xb; GAS float* ssout; float alpha;
    __device__ __forceinline__ void operator()(f32x4 (&acc)[2][2][4][2], const Unit& u, int wr, int wc, int fr, int fq) const {
        const int row0 = u.pm * BM + wr * 64 + fr, col0 = u.pn * BM + wc * 32 + 8 * fq;
        const GAS void* bs = u.pm < 128 ? base : base2;
        if constexpr (BASE_F32) {
#pragma unroll
            for (int am = 0; am < 4; ++am) {
                const int ai = am >> 1, mh = am & 1;
                f32x4 bv[2][2][2];
#pragma unroll
                for (int mm = 0; mm < 2; ++mm)
#pragma unroll
                    for (int bj = 0; bj < 2; ++bj) { const size_t off = (size_t)(row0 + ai * HALF + (2 * mh + mm) * 16) * DM + col0 + bj * HALF;
                        bv[mm][bj][0] = *(const GAS f32x4*)((const GAS float*)bs + off); bv[mm][bj][1] = *(const GAS f32x4*)((const GAS float*)bs + off + 4); }
                asm volatile("" ::: "memory");
#pragma unroll
                for (int mm = 0; mm < 2; ++mm) {
                    const int m = 2 * mh + mm;
                    const int r = row0 + ai * HALF + m * 16; const size_t off = (size_t)r * DM + col0; float q = 0.f;
#pragma unroll
                    for (int bj = 0; bj < 2; ++bj) {
                        const f32x4 o0 = bv[mm][bj][0] + acc[ai][bj][m][0] * alpha, o1 = bv[mm][bj][1] + acc[ai][bj][m][1] * alpha;
                        q += (o0[0] * o0[0] + o0[1] * o0[1]) + (o0[2] * o0[2] + o0[3] * o0[3]) + (o1[0] * o1[0] + o1[1] * o1[1]) + (o1[2] * o1[2] + o1[3] * o1[3]);
                        u32x4 w; w.x = cvt_pk_bf16(o0[0], o0[1]); w.y = cvt_pk_bf16(o0[2], o0[3]); w.z = cvt_pk_bf16(o1[0], o1[1]); w.w = cvt_pk_bf16(o1[2], o1[3]);
                        *(GAS u32x4*)(xb + off + bj * HALF) = w;
                    }
                    q += __shfl_xor(q, 16); q += __shfl_xor(q, 32); if (fq == 0) __builtin_amdgcn_global_atomic_fadd_f32(ssout + r, q);
                }
            }
        } else {
#pragma unroll
            for (int ai = 0; ai < 2; ++ai) {
                u32x4 bv[4][2];
#pragma unroll
                for (int m = 0; m < 4; ++m)
#pragma unroll
                    for (int bj = 0; bj < 2; ++bj) bv[m][bj] = *(const GAS u32x4*)((const GAS bf16_t*)bs + (size_t)(row0 + ai * HALF + m * 16) * DM + col0 + bj * HALF);
                asm volatile("" ::: "memory");
#pragma unroll
                for (int m = 0; m < 4; ++m) {
                    const int r = row0 + ai * HALF + m * 16; const size_t off = (size_t)r * DM + col0; float q = 0.f;
#pragma unroll
                    for (int bj = 0; bj < 2; ++bj) {
                        const u32x4 bb = bv[m][bj];
                        const f32x4 b0 = (f32x4){bf_lo(bb.x), bf_hi(bb.x), bf_lo(bb.y), bf_hi(bb.y)}, b1 = (f32x4){bf_lo(bb.z), bf_hi(bb.z), bf_lo(bb.w), bf_hi(bb.w)};
                        const f32x4 o0 = b0 + acc[ai][bj][m][0] * alpha, o1 = b1 + acc[ai][bj][m][1] * alpha;
                        q += (o0[0] * o0[0] + o0[1] * o0[1]) + (o0[2] * o0[2] + o0[3] * o0[3]) + (o1[0] * o1[0] + o1[1] * o1[1]) + (o1[2] * o1[2] + o1[3] * o1[3]);
                        u32x4 w; w.x = cvt_pk_bf16(o0[0], o0[1]); w.y = cvt_pk_bf16(o0[2], o0[3]); w.z = cvt_pk_bf16(o1[0], o1[1]); w.w = cvt_pk_bf16(o1[2], o1[3]);
                        *(GAS u32x4*)(xb + off + bj * HALF) = w;
                    }
                    q += __shfl_xor(q, 16); q += __shfl_xor(q, 32); if (fq == 0) __builtin_amdgcn_global_atomic_fadd_f32(ssout + r, q);
                }
            }
        }
    }
};
struct EpiFinal {   static constexpr bool SSPRE = false;
    const GAS bf16_t* base; GAS float* out; const GAS float* gain; float* xbuf; unsigned* cnt; LAS float* red; float alpha;
    __device__ __forceinline__ void operator()(f32x4 (&acc)[2][2][4][2], const Unit& u, int wr, int wc, int fr, int fq) const {
        const int tid = threadIdx.x, lane = tid & 63, wid = tid >> 6;
        const int row0 = u.pm * BM + wr * 64 + fr, col0 = u.pn * BM + wc * 32 + 8 * fq;
        LAS float* S = red + 1024;
#pragma unroll
        for (int ai = 0; ai < 2; ++ai) {
            u32x4 bv[4][2];
#pragma unroll
            for (int m = 0; m < 4; ++m)
#pragma unroll
                for (int bj = 0; bj < 2; ++bj) bv[m][bj] = *(const GAS u32x4*)(base + (size_t)(row0 + ai * HALF + m * 16) * DM + col0 + bj * HALF);
#pragma unroll
            for (int m = 0; m < 4; ++m) {
                float q = 0.f;
#pragma unroll
                for (int bj = 0; bj < 2; ++bj) {
                    const u32x4 bb = bv[m][bj];
                    const f32x4 b0 = (f32x4){bf_lo(bb.x), bf_hi(bb.x), bf_lo(bb.y), bf_hi(bb.y)}, b1 = (f32x4){bf_lo(bb.z), bf_hi(bb.z), bf_lo(bb.w), bf_hi(bb.w)};
                    const f32x4 o0 = b0 + acc[ai][bj][m][0] * alpha, o1 = b1 + acc[ai][bj][m][1] * alpha;
                    q += (o0[0] * o0[0] + o0[1] * o0[1]) + (o0[2] * o0[2] + o0[3] * o0[3]) + (o1[0] * o1[0] + o1[1] * o1[1]) + (o1[2] * o1[2] + o1[3] * o1[3]);
                    acc[ai][bj][m][0] = o0; acc[ai][bj][m][1] = o1;
                }
                q += __shfl_xor(q, 16); q += __shfl_xor(q, 32);
                if (fq == 0) red[(ai * HALF + wr * 64 + m * 16 + fr) * 4 + wc] = q;
            }
        }
        asm volatile("s_waitcnt lgkmcnt(0)" ::: "memory"); __builtin_amdgcn_s_barrier(); asm volatile("" ::: "memory");
        if (tid < 256) {
            const f32x4 r4 = *(const LAS f32x4*)(red + tid * 4);
            __hip_atomic_store(xbuf + ((size_t)(u.pm * BM + tid) * 4 + u.pn), (r4[0] + r4[1]) + (r4[2] + r4[3]), __ATOMIC_RELAXED, __HIP_MEMORY_SCOPE_AGENT);
        }
        asm volatile("s_waitcnt vmcnt(0) lgkmcnt(0)" ::: "memory");
        if (tid < 256 && lane == 0) __hip_atomic_fetch_add(cnt + 64 * u.pm, 1u, __ATOMIC_RELAXED, __HIP_MEMORY_SCOPE_AGENT);
        if (wid == 0) {
            unsigned sp = 0;
            while ((unsigned)__builtin_amdgcn_readfirstlane(__hip_atomic_load(cnt + 64 * u.pm, __ATOMIC_RELAXED, __HIP_MEMORY_SCOPE_AGENT)) < 16u) { __builtin_amdgcn_s_sleep(2); if (++sp > (1u << 22)) break; }
            __builtin_amdgcn_fence(__ATOMIC_ACQUIRE, "agent");
        }
        asm volatile("s_waitcnt vmcnt(0) lgkmcnt(0)" ::: "memory"); __builtin_amdgcn_s_barrier(); asm volatile("" ::: "memory");
        if (tid < 256) {
            const float* slot = xbuf + (size_t)(u.pm * BM + tid) * 4;
            const float t0 = __hip_atomic_load(slot + 0, __ATOMIC_RELAXED, __HIP_MEMORY_SCOPE_AGENT), t1 = __hip_atomic_load(slot + 1, __ATOMIC_RELAXED, __HIP_MEMORY_SCOPE_AGENT),
                        t2 = __hip_atomic_load(slot + 2, __ATOMIC_RELAXED, __HIP_MEMORY_SCOPE_AGENT), t3 = __hip_atomic_load(slot + 3, __ATOMIC_RELAXED, __HIP_MEMORY_SCOPE_AGENT);
            S[tid] = rsqrtf(((t0 + t1) + (t2 + t3)) * (1.0f / 1024.0f) + EPS);
        }
        asm volatile("s_waitcnt vmcnt(0) lgkmcnt(0)" ::: "memory"); __builtin_amdgcn_s_barrier(); asm volatile("" ::: "memory");
        f32x4 gv[2][2];
#pragma unroll
        for (int bj = 0; bj < 2; ++bj) { gv[bj][0] = *(const GAS f32x4*)(gain + col0 + bj * HALF); gv[bj][1] = *(const GAS f32x4*)(gain + col0 + bj * HALF + 4); }
#pragma unroll
        for (int ai = 0; ai < 2; ++ai)
#pragma unroll
            for (int m = 0; m < 4; ++m) {
                const int rl = ai * HALF + wr * 64 + m * 16 + fr; const float sc = S[rl];
                GAS float* rowp = out + (size_t)(u.pm * BM + rl) * DM + col0;
#pragma unroll
                for (int bj = 0; bj < 2; ++bj) {
                    *(GAS f32x4*)(rowp + bj * HALF) = acc[ai][bj][m][0] * sc * gv[bj][0];
                    *(GAS f32x4*)(rowp + bj * HALF + 4) = acc[ai][bj][m][1] * sc * gv[bj][1];
                }
            }
    }
};
struct EpiSoftmax { static constexpr bool SSPRE = false;
    GAS bf16_t* O; LAS float* red;
    __device__ __forceinline__ void operator()(f32x4 (&acc)[2][2][4][2], const Unit& u, int wr, int wc, int fr, int fq) const {
        const int row0 = u.pm * BM + wr * 64 + fr, col0 = u.pn * BM + wc * 32 + 8 * fq;
        LAS float* red2 = red + 1024;
#pragma unroll
        for (int ai = 0; ai < 2; ++ai)
#pragma unroll
            for (int m = 0; m < 4; ++m) {
                float v = -3.0e38f;
#pragma unroll
                for (int bj = 0; bj < 2; ++bj)
#pragma unroll
                    for (int n = 0; n < 2; ++n) { const f32x4 x = acc[ai][bj][m][n]; v = fmaxf(v, fmaxf(fmaxf(x[0], x[1]), fmaxf(x[2], x[3]))); }
                v = fmaxf(v, __shfl_xor(v, 16)); v = fmaxf(v, __shfl_xor(v, 32));
                if (fq == 0) red[(ai * HALF + wr * 64 + m * 16 + fr) * 4 + wc] = v;
            }
        asm volatile("s_waitcnt lgkmcnt(0)" ::: "memory"); __builtin_amdgcn_s_barrier(); asm volatile("" ::: "memory");
#pragma unroll
        for (int ai = 0; ai < 2; ++ai)
#pragma unroll
            for (int m = 0; m < 4; ++m) {
                const int rl = ai * HALF + wr * 64 + m * 16 + fr;
                const f32x4 r4 = *(const LAS f32x4*)(red + rl * 4);
                const float mx = fmaxf(fmaxf(r4[0], r4[1]), fmaxf(r4[2], r4[3])) * LOG2E; float sum = 0.f;
#pragma unroll
                for (int bj = 0; bj < 2; ++bj)
#pragma unroll
                    for (int n = 0; n < 2; ++n) {
                        f32x4 x = acc[ai][bj][m][n];
#pragma unroll
                        for (int e = 0; e < 4; ++e) { x[e] = __builtin_amdgcn_exp2f(x[e] * LOG2E - mx); sum += x[e]; }
                        acc[ai][bj][m][n] = x;
                    }
                sum += __shfl_xor(sum, 16); sum += __shfl_xor(sum, 32);
                if (fq == 0) red2[rl * 4 + wc] = sum;
            }
        asm volatile("s_waitcnt lgkmcnt(0)" ::: "memory"); __builtin_amdgcn_s_barrier(); asm volatile("" ::: "memory");
#pragma unroll
        for (int ai = 0; ai < 2; ++ai)
#pragma unroll
            for (int m = 0; m < 4; ++m) {
                const int rl = ai * HALF + wr * 64 + m * 16 + fr; const int r = row0 + ai * HALF + m * 16;
                const f32x4 r4 = *(const LAS f32x4*)(red2 + rl * 4);
                const float inv = 1.0f / ((r4[0] + r4[1]) + (r4[2] + r4[3]));
                GAS bf16_t* rowp = O + (size_t)r * DM + col0;
#pragma unroll
                for (int bj = 0; bj < 2; ++bj) {
                    const f32x4 v0 = acc[ai][bj][m][0] * inv, v1 = acc[ai][bj][m][1] * inv;
                    u32x4 w; w.x = cvt_pk_bf16(v0[0], v0[1]); w.y = cvt_pk_bf16(v0[2], v0[3]); w.z = cvt_pk_bf16(v1[0], v1[1]); w.w = cvt_pk_bf16(v1[2], v1[3]);
                    *(GAS u32x4*)(rowp + bj * HALF) = w;
                }
            }
    }
};

template <class Epi, class Sched>
__device__ __forceinline__ void gemm_phase(LAS unsigned char* lds, const Gemm g, const Sched& S, const Epi& E) {
    int tid_ = threadIdx.x; asm volatile("" : "+v"(tid_));
    const int tid = tid_, wid = __builtin_amdgcn_readfirstlane(tid >> 6), lane = tid & 63, wr = wid >> 2, wc = wid & 3, fr = lane & 15, fq = lane >> 4;
    const int nt = g.K / BK;
    unsigned voffA[2], voffB[2];
#pragma unroll
    for (int i = 0; i < 2; ++i) { int R, C; stage_rc(tid * 16 + i * 8192, R, C); const int Rb = (R & ~31) + perm32(R & 31);
        voffA[i] = (unsigned)(R * g.lda + C) * 2u; voffB[i] = (unsigned)(Rb * g.ldb + C) * 2u; }
    const size_t kstep = (size_t)(BK * 2);
    const size_t hstepA = (size_t)HALF * g.lda * 2, hstepB = (size_t)HALF * g.ldb * 2;
    const unsigned ldsw = (unsigned)wid * 1024u;
    const int aoff = lds_byte(wr * 64 + fr, fq * 8), boff = lds_byte(wc * 32 + fr, fq * 8);
#define PG8_SA(b, h) (((b) * 2 + (h)) * HTB)
#define PG8_SB(b, h) ((4 + (b) * 2 + (h)) * HTB)
#define PG8_STAGE(bufoff, gbase, voff) do { _Pragma("unroll") for (int _i = 0; _i < 2; ++_i) \
        __builtin_amdgcn_global_load_lds((const GAS unsigned*)((gbase) + (voff)[_i]), (LAS unsigned*)(lds + (bufoff) + ldsw + _i * 8192), 16, 0, 0); } while (0)
#define PG8_LDA(dst, b, h) do { _Pragma("unroll") for (int m = 0; m < 4; ++m) _Pragma("unroll") for (int k = 0; k < 2; ++k) dst[m][k] = *(const LAS bf16x8*)(lds + PG8_SA(b, h) + aoff + m * 2048 + k * 1024); } while (0)
#define PG8_LDB(dst, b, h) do { _Pragma("unroll") for (int n = 0; n < 2; ++n) _Pragma("unroll") for (int k = 0; k < 2; ++k) dst[n][k] = *(const LAS bf16x8*)(lds + PG8_SB(b, h) + boff + n * 2048 + k * 1024); } while (0)
#define PG8_MMA(ai, bj, At, Bt) do { _Pragma("unroll") for (int m = 0; m < 4; ++m) _Pragma("unroll") for (int n = 0; n < 2; ++n) _Pragma("unroll") for (int k = 0; k < 2; ++k) \
        acc[ai][bj][m][n] = __builtin_amdgcn_mfma_f32_16x16x32_bf16(Bt[n][k], At[m][k], acc[ai][bj][m][n], 0, 0, 0); } while (0)
#define PG8_WAIT_V(n) asm volatile("s_waitcnt vmcnt(" #n ")" ::: "memory")
#define PG8_WAIT_L(n) asm volatile("s_waitcnt lgkmcnt(" #n ")" ::: "memory")
#define PG8_BAR __builtin_amdgcn_s_barrier()
#define PG8_SCHED __builtin_amdgcn_sched_barrier(0)
    Unit cur, nxt; int ui = 0;
    if (!S.next(0, cur)) return;
    f32x4 acc[2][2][4][2];
#pragma unroll
    for (int a = 0; a < 2; ++a)
#pragma unroll
        for (int b = 0; b < 2; ++b)
#pragma unroll
            for (int m = 0; m < 4; ++m)
#pragma unroll
                for (int n = 0; n < 2; ++n) acc[a][b][m][n] = (f32x4){0.f, 0.f, 0.f, 0.f};
    bf16x8 At[4][2], B0[2][2], B1[2][2];
    const GAS char* cA = cur.A; const GAS char* cB = cur.B;
    LAS float* scb = (LAS float*)(lds + 140288);
    if constexpr (Epi::SSPRE) { if (tid < 256) scb[tid] = __builtin_amdgcn_rsqf(E.ss[cur.pm * BM + tid] * (1.0f / 1024.0f) + EPS); }
    PG8_STAGE(PG8_SB(0, 0), cB, voffB); PG8_STAGE(PG8_SB(0, 1), cB + hstepB, voffB); PG8_STAGE(PG8_SA(0, 0), cA, voffA); PG8_STAGE(PG8_SA(0, 1), cA + hstepA, voffA);
    if (wr == 1) PG8_BAR;
    PG8_WAIT_V(2); PG8_BAR;
    PG8_STAGE(PG8_SB(1, 0), cB + kstep, voffB); PG8_STAGE(PG8_SB(1, 1), cB + hstepB + kstep, voffB);
    PG8_WAIT_V(6); PG8_BAR;
    for (;;) {
        const bool has_next = S.next(ui + 1, nxt);
        const GAS char* nA = has_next ? nxt.A : cA; const GAS char* nB = has_next ? nxt.B : cB;
#pragma unroll 1
        for (int t = 0; t < nt; t += 2) {
            const bool last = (t == nt - 2);
            const GAS char* a1 = cA + (size_t)(t + 1) * kstep;
            const GAS char* a2 = last ? nA : cA + (size_t)(t + 2) * kstep; const GAS char* b2 = last ? nB : cB + (size_t)(t + 2) * kstep;
            const GAS char* b3 = b2 + kstep;
            PG8_LDB(B0, 0, 0); PG8_LDB(B1, 0, 1); PG8_SCHED; PG8_LDA(At, 0, 0); PG8_STAGE(PG8_SA(1, 0), a1, voffA); PG8_STAGE(PG8_SA(1, 1), a1 + hstepA, voffA);
            PG8_WAIT_V(8); PG8_WAIT_L(0); __builtin_amdgcn_s_setprio(1); PG8_BAR; PG8_MMA(0, 0, At, B0); PG8_MMA(0, 1, At, B1); __builtin_amdgcn_s_setprio(0); PG8_BAR; PG8_SCHED;
            PG8_LDA(At, 0, 1); PG8_STAGE(PG8_SB(0, 0), b2, voffB); PG8_STAGE(PG8_SB(0, 1), b2 + hstepB, voffB);
            PG8_WAIT_V(6); PG8_WAIT_L(0); __builtin_amdgcn_s_setprio(1); PG8_BAR; PG8_MMA(1, 0, At, B0); PG8_MMA(1, 1, At, B1); __builtin_amdgcn_s_setprio(0); PG8_BAR; PG8_SCHED;
            PG8_LDB(B0, 1, 0); PG8_LDB(B1, 1, 1); PG8_SCHED; PG8_LDA(At, 1, 0); PG8_STAGE(PG8_SA(0, 0), a2, voffA); PG8_STAGE(PG8_SA(0, 1), a2 + hstepA, voffA);
            PG8_WAIT_V(8); PG8_WAIT_L(0); __builtin_amdgcn_s_setprio(1); PG8_BAR; PG8_MMA(0, 0, At, B0); PG8_MMA(0, 1, At, B1); __builtin_amdgcn_s_setprio(0); PG8_BAR; PG8_SCHED;
            PG8_LDA(At, 1, 1); PG8_STAGE(PG8_SB(1, 0), b3, voffB); PG8_STAGE(PG8_SB(1, 1), b3 + hstepB, voffB);
            PG8_WAIT_V(6); PG8_WAIT_L(0); __builtin_amdgcn_s_setprio(1); PG8_BAR; PG8_MMA(1, 0, At, B0); PG8_MMA(1, 1, At, B1); __builtin_amdgcn_s_setprio(0); PG8_BAR; PG8_SCHED;
        }
        if (wr == 0) PG8_BAR;
        if constexpr (Epi::SSPRE) {
            const bool pf = has_next && tid < 256;
            const float nv = E.ss[(has_next ? nxt.pm : cur.pm) * BM + (tid & 255)];
            E(acc, cur, wr, wc, fr, fq, scb + (ui & 1) * 256, ScNext{nv, scb + ((ui + 1) & 1) * 256 + (tid & 255), pf});
        } else E(acc, cur, wr, wc, fr, fq);
        if (!has_next) break;
#pragma unroll
        for (int a = 0; a < 2; ++a)
#pragma unroll
            for (int b = 0; b < 2; ++b)
#pragma unroll
                for (int m = 0; m < 4; ++m)
#pragma unroll
                    for (int n = 0; n < 2; ++n) acc[a][b][m][n] = (f32x4){0.f, 0.f, 0.f, 0.f};
        cur = nxt; cA = nA; cB = nB; ++ui;
        if (wr == 1) PG8_BAR;
    }
    PG8_WAIT_V(0);
    PG8_BAR;
#undef PG8_SA
#undef PG8_SB
#undef PG8_STAGE
#undef PG8_LDA
#undef PG8_LDB
#undef PG8_MMA
#undef PG8_WAIT_V
#undef PG8_WAIT_L
#undef PG8_BAR
#undef PG8_SCHED
}
}

constexpr int LDS_BYTES = 143360;
constexpr int LDS_RED_OFF = 131072;
constexpr int MIXSTR = 1032;
constexpr int LDS_PART_OFF = 128 * MIXSTR;
static_assert(LDS_PART_OFF + 4096 <= LDS_BYTES && LDS_RED_OFF + 8192 <= LDS_BYTES && 140288 + 2048 <= LDS_BYTES, "LDS map");

struct Params { const float* in[26]; float* out; unsigned char* ws; };
constexpr int LDS_PTR_OFF = 139264;
__device__ __forceinline__ GAS unsigned char* ldptr(LAS unsigned char* lds, int i) {
    const u32x2 v = *(const LAS u32x2*)(lds + LDS_PTR_OFF + 8 * i);
    const unsigned lo = __builtin_amdgcn_readfirstlane(v.x), hi = __builtin_amdgcn_readfirstlane(v.y);
    return (GAS unsigned char*)(((unsigned long long)hi << 32) | lo);
}
#define INP(k) ((const GAS float*)ldptr(lds, (k)))
#define WSP(off) (ldptr(lds, 27) + (off))
#define OUTP ((GAS float*)ldptr(lds, 26))
#ifndef PHMASK
#define PHMASK 0xFFFF
#endif
#define PH(n) if constexpr (((PHMASK) >> (n)) & 1)
#define LOCAL_SEAM() do { asm volatile("s_waitcnt vmcnt(0)" ::: "memory"); __syncthreads(); __builtin_amdgcn_fence(__ATOMIC_ACQUIRE, "agent"); asm volatile("s_waitcnt vmcnt(0)" ::: "memory"); __syncthreads(); } while (0)

__device__ __forceinline__ int rowmap(int mode, int n0) {
    if (mode == 1) { const int isu = n0 >= DFF, j = isu ? n0 - DFF : n0; return 256 * (j >> 7) + 128 * isu + (j & 127); }
    if (mode == 2) { if (n0 < 512 || n0 >= 1536) return n0; const int isx = n0 >= 1024, j = n0 - (isx ? 1024 : 512); return 512 + 256 * (j >> 7) + 128 * isx + (j & 127); }
    return n0;
}
__device__ __forceinline__ void tr_item(const GAS float* W, int K, int N, GAS bf16_t* WT, int mode, const GAS float* gain, float cst, LAS float* scr, int item, int lane) {
    const int nblk = N / 32, kb = item / nblk, nb = item % nblk, k0 = 64 * kb, n0 = 32 * nb;
#pragma unroll
    for (int i = 0; i < 32; ++i) { const int kk = 2 * i + (lane >> 5); const float gsc = gain ? gain[k0 + kk] * cst : cst;
        scr[kk * 33 + (lane & 31)] = W[(size_t)(k0 + kk) * N + n0 + (lane & 31)] * gsc; }
    asm volatile("s_waitcnt lgkmcnt(0)" ::: "memory");
    const int c = lane & 7, drow0 = rowmap(mode, n0);
#pragma unroll
    for (int j = 0; j < 4; ++j) { const int n = (lane >> 3) + 8 * j; const LAS float* s = scr + (8 * c) * 33 + n;
        u32x4 o; o.x = cvt_pk_bf16(s[0 * 33], s[1 * 33]); o.y = cvt_pk_bf16(s[2 * 33], s[3 * 33]); o.z = cvt_pk_bf16(s[4 * 33], s[5 * 33]); o.w = cvt_pk_bf16(s[6 * 33], s[7 * 33]);
        *(GAS u32x4*)(WT + (size_t)(drow0 + n) * K + k0 + 8 * c) = o; }
    asm volatile("s_waitcnt lgkmcnt(0)" ::: "memory");
}


#define XB_TMO      128
#define XB_XCNT(j)  (256  + 64 * (j))
#define XB_XSUB(j)  (1280 + 64 * (j))
#define XB_XGEN(j)  (2304 + 64 * (j))
#define XB_TOP      3328
#define XB_TOPGEN   3392
#define XCD_BAR_WORDS 3456
#define XB_SPIN_CAP (1u << 22)
__device__ __forceinline__ unsigned xb_ld(unsigned* p)              { return __hip_atomic_load(p, __ATOMIC_RELAXED, __HIP_MEMORY_SCOPE_AGENT); }
__device__ __forceinline__ unsigned xb_add(unsigned* p, unsigned v) { return __hip_atomic_fetch_add(p, v, __ATOMIC_RELAXED, __HIP_MEMORY_SCOPE_AGENT); }
__device__ __forceinline__ unsigned xb_xcc_id() { return (unsigned)__builtin_amdgcn_s_getreg((3 << 11) | 20) & 0xFu; }
#define XB_SPIN(cond, bar) do { unsigned _sp = 0; while (cond) { __builtin_amdgcn_s_sleep(1); \
    if ((++_sp & 255u) == 0u) { if (xb_ld(&(bar)[XB_TMO])) break; if (_sp > XB_SPIN_CAP) { atomicAdd(&(bar)[XB_TMO], 1u); break; } } } } while (0)
struct XcdBarrier { unsigned* bar; unsigned x; volatile LAS unsigned* st; };
__device__ __forceinline__ XcdBarrier xcd_barrier_post(unsigned* bar, volatile LAS unsigned* st) {
    XcdBarrier b; b.bar = bar; b.x = xb_xcc_id(); b.st = st;
    if (threadIdx.x == 0) (void)xb_add(&bar[XB_XCNT(b.x)], 1u);
    return b;
}
__device__ __forceinline__ void xcd_barrier_complete(unsigned* bar, unsigned x, unsigned& nloc, unsigned& nx) {
    const unsigned G = gridDim.x * gridDim.y * gridDim.z;
    unsigned sum, cnt, mine, sp = 0u;
    for (;;) {
        sum = 0u; cnt = 0u; mine = 0u;
#pragma unroll
        for (unsigned j = 0; j < 16; ++j) { const unsigned c = xb_ld(&bar[XB_XCNT(j)]); sum += c; cnt += (c > 0u) ? 1u : 0u; mine = (j == x) ? c : mine; }
        if (sum == G) break;
        __builtin_amdgcn_s_sleep(1);
        if ((++sp & 255u) == 0u) { if (xb_ld(&bar[XB_TMO])) break; if (sp > XB_SPIN_CAP) { atomicAdd(&bar[XB_TMO], 1u); break; } }
    }
    nloc = mine > 0u ? mine : 1u; nx = cnt > 0u ? cnt : 1u;
}
__device__ __forceinline__ void xcd_barrier(const XcdBarrier& b) {
    asm volatile("s_waitcnt vmcnt(0)" ::: "memory");
    __syncthreads();
    if (threadIdx.x == 0) {
        unsigned* bar = b.bar;
        __builtin_amdgcn_s_waitcnt(0);
        unsigned nloc = b.st[0], nx = b.st[1];
        if (nloc == 0u) { xcd_barrier_complete(bar, b.x, nloc, nx); b.st[0] = nloc; b.st[1] = nx; }
        const unsigned old = xb_add(&bar[XB_XSUB(b.x)], 1u);
        const unsigned gen = old / nloc;
        if (old + 1u == (gen + 1u) * nloc) {
            __builtin_amdgcn_fence(__ATOMIC_RELEASE, "agent");
            asm volatile("s_waitcnt vmcnt(0)" ::: "memory");
            const unsigned og = xb_add(&bar[XB_TOP], 1u);
            const unsigned tg = og / nx;
            if (og + 1u == (tg + 1u) * nx) xb_add(&bar[XB_TOPGEN], 1u);
            else XB_SPIN(xb_ld(&bar[XB_TOPGEN]) == tg, bar);
            __builtin_amdgcn_fence(__ATOMIC_ACQUIRE, "agent");
            xb_add(&bar[XB_XGEN(b.x)], 1u);
            asm volatile("s_waitcnt vmcnt(0)" ::: "memory");
        } else {
            XB_SPIN(xb_ld(&bar[XB_XGEN(b.x)]) == gen, bar);
            __builtin_amdgcn_fence(__ATOMIC_ACQUIRE, "agent");
            asm volatile("s_waitcnt vmcnt(0)" ::: "memory");
        }
    }
    __syncthreads();
}

__global__ void __launch_bounds__(512, 2) mega_fwd(Params p) {
    extern __shared__ __attribute__((aligned(16))) unsigned char lds_raw[];
    LAS unsigned char* lds = (LAS unsigned char*)lds_raw;
    cg::grid_group grid = cg::this_grid();
    const int tid = threadIdx.x, lane = tid & 63, wave = __builtin_amdgcn_readfirstlane(tid >> 6);
    const int G = gridDim.x, bx = blockIdx.x, vcu = (G % 8 == 0) ? (bx % 8) * (G / 8) + bx / 8 : bx;
    if (tid == 0) {
#pragma unroll
        for (int i = 0; i < 26; ++i) *(LAS unsigned long long*)(lds + LDS_PTR_OFF + 8 * i) = (unsigned long long)p.in[i];
        *(LAS unsigned long long*)(lds + LDS_PTR_OFF + 8 * 26) = (unsigned long long)p.out;
        *(LAS unsigned long long*)(lds + LDS_PTR_OFF + 8 * 27) = (unsigned long long)p.ws;
        *(LAS unsigned long long*)(lds + LDS_PTR_OFF + 256) = 0ull;
    }
    __syncthreads();
#define ss0 ((GAS float*)WSP(WS_SS))
#define ss1 (ss0 + T_TOK)
#define ss2 (ss0 + 2 * T_TOK)
#define ss3 (ss0 + 3 * T_TOK)
#define ss4 (ss0 + 4 * T_TOK)
#define Wgu1 ((GAS bf16_t*)WSP(WS_WGU1))
#define Wd1 ((GAS bf16_t*)WSP(WS_WD1))
#define Win ((GAS bf16_t*)WSP(WS_WIN))
#define Wout ((GAS bf16_t*)WSP(WS_WOUT))
#define Wq ((GAS bf16_t*)WSP(WS_WQ))
#define Wkv ((GAS bf16_t*)WSP(WS_WKV))
#define Wo ((GAS bf16_t*)WSP(WS_WO))
#define Wgu2 ((GAS bf16_t*)WSP(WS_WGU2))
#define Wd2 ((GAS bf16_t*)WSP(WS_WD2))
#define Wsb ((GAS bf16_t*)WSP(WS_WSB))
#define memn ((GAS bf16_t*)WSP(WS_MEMN))
#define Kmat ((GAS bf16_t*)WSP(WS_KMAT))
#define Vt ((GAS bf16_t*)WSP(WS_VT))
#define R1 ((GAS bf16_t*)WSP(WS_R1))
#define R2 ((GAS bf16_t*)WSP(WS_R2))
#define DO_LO ((GAS bf16_t*)OUTP)
#define DO_HI ((GAS bf16_t*)((GAS unsigned char*)OUTP + 128 * MiB))
#define HSPLIT 229
#define HTAIL (DO_LO - (size_t)HSPLIT * 256 * DFF)
#define XB0 ((GAS bf16_t*)((GAS unsigned char*)OUTP + 128 * MiB))
    if (bx == 0) { for (int i = tid; i < XCD_BAR_WORDS; i += 512) ((GAS unsigned*)WSP(WS_BAR))[i] = 0u; }
    if (bx == 1 % G) { for (int i = tid; i < 256; i += 512) ((GAS unsigned*)WSP(WS_CNT))[64 * i] = 0u; }
    PH(0) {
        LAS float* scr = (LAS float*)(lds + wave * 16384);
        const int gw = vcu * 8 + wave, NGW = G * 8;
        constexpr int I_GU = 16 * 176, I_DN = 44 * 32, I_IN = 16 * 80, I_SQ = 16 * 32, I_KV = 16 * 64;
        constexpr int NITEMS = 2 * I_GU + 2 * I_DN + I_IN + 3 * I_SQ + I_KV;
        for (int it = gw; it < NITEMS; it += NGW) {
            int r = it;
            if (r < I_GU) { tr_item(INP(5), DM, NGU, Wgu1, 1, INP(4), 1.f, scr, r, lane); continue; } r -= I_GU;
            if (r < I_GU) { tr_item(INP(23), DM, NGU, Wgu2, 1, INP(22), 1.f, scr, r, lane); continue; } r -= I_GU;
            if (r < I_DN) { tr_item(INP(6), DFF, DM, Wd1, 0, nullptr, 1.f, scr, r, lane); continue; } r -= I_DN;
            if (r < I_DN) { tr_item(INP(24), DFF, DM, Wd2, 0, nullptr, 1.f, scr, r, lane); continue; } r -= I_DN;
            if (r < I_IN) { tr_item(INP(8), DM, DIN, Win, 2, INP(7), 1.f, scr, r, lane); continue; } r -= I_IN;
            if (r < I_SQ) { tr_item(INP(16), DM, DM, Wout, 0, nullptr, 1.f, scr, r, lane); continue; } r -= I_SQ;
            if (r < I_SQ) { tr_item(INP(19), DM, DM, Wq, 0, INP(18), 0.0625f, scr, r, lane); continue; } r -= I_SQ;
            if (r < I_SQ) { tr_item(INP(21), DM, DM, Wo, 0, nullptr, 1.f, scr, r, lane); continue; } r -= I_SQ;
            tr_item(INP(20), DM, 2 * DM, Wkv, 0, nullptr, 1.f, scr, r, lane);
        }
        for (int i = (gw * 64 + lane) * 4; i < 8 * 128 * 128; i += NGW * 64 * 4) {
            const f32x4 v = *(const GAS f32x4*)(INP(10) + i); u32x2 w; w.x = cvt_pk_bf16(v[0], v[1]); w.y = cvt_pk_bf16(v[2], v[3]); *(GAS u32x2*)(Wsb + i) = w; }
        f32x4 gmem[4];
#pragma unroll
        for (int j = 0; j < 4; ++j) gmem[j] = *(const GAS f32x4*)(INP(17) + 4 * lane + 256 * j);
        for (int m = gw; m < NMEMROWS; m += NGW) {
            const GAS float* src = m < 2048 ? INP(2) + (size_t)m * DM : INP(3) + (size_t)(m - 2048) * DM;
            f32x4 v[4]; float s = 0.f;
#pragma unroll
            for (int j = 0; j < 4; ++j) { v[j] = *(const GAS f32x4*)(src + 4 * lane + 256 * j); s += (v[j][0] * v[j][0] + v[j][1] * v[j][1]) + (v[j][2] * v[j][2] + v[j][3] * v[j][3]); }
            const float sc = rsqrtf(wave_sum(s) * (1.0f / 1024.0f) + EPS);
#pragma unroll
            for (int j = 0; j < 4; ++j) { const f32x4 o = v[j] * sc * gmem[j];
                u32x2 w; w.x = cvt_pk_bf16(o[0], o[1]); w.y = cvt_pk_bf16(o[2], o[3]); *(GAS u32x2*)(memn + (size_t)m * DM + 4 * lane + 256 * j) = w; }
        }
#define XLOAD(M0_, V_) do { _Pragma("unroll") for (int u = 0; u < 4; ++u) { const int m = (M0_) + u * NGW; if (m < T_TOK) { const GAS float* src = m < T_HALF ? INP(0) + (size_t)m * DM : INP(1) + (size_t)(m - T_HALF) * DM; \
            _Pragma("unroll") for (int j = 0; j < 4; ++j) V_[u][j] = __builtin_nontemporal_load((const GAS f32x4*)(src + 4 * lane + 256 * j)); } } } while (0)
        {
            f32x4 v[4][4], vn[4][4];
            if (gw < T_TOK) XLOAD(gw, v);
#pragma unroll 1
            for (int m0 = gw; m0 < T_TOK; m0 += 4 * NGW) {
                if (m0 + 4 * NGW < T_TOK) XLOAD(m0 + 4 * NGW, vn);
#pragma unroll
                for (int u = 0; u < 4; ++u) { const int m = m0 + u * NGW; if (m < T_TOK) { float sq = 0.f;
#pragma unroll
                    for (int j = 0; j < 4; ++j) { sq += (v[u][j][0] * v[u][j][0] + v[u][j][1] * v[u][j][1]) + (v[u][j][2] * v[u][j][2] + v[u][j][3] * v[u][j][3]);
                        u32x2 w; w.x = cvt_pk_bf16(v[u][j][0], v[u][j][1]); w.y = cvt_pk_bf16(v[u][j][2], v[u][j][3]); *(GAS u32x2*)(XB0 + (size_t)m * DM + 4 * lane + 256 * j) = w; }
                    sq = wave_sum(sq);
                    if (lane == 0) { ss0[m] = sq; ss1[m] = 0.f; ss2[m] = 0.f; ss3[m] = 0.f; ss4[m] = 0.f; } } }
#pragma unroll
                for (int u = 0; u < 4; ++u)
#pragma unroll
                    for (int j = 0; j < 4; ++j) v[u][j] = vn[u][j];
            }
        }
#undef XLOAD
    }
    grid.sync();
    XcdBarrier xbar = xcd_barrier_post((unsigned*)WSP(WS_BAR), (volatile LAS unsigned*)(lds + LDS_PTR_OFF + 256));

    const unsigned T1K = 256u * 1024u * 2u;
    PH(1) {
        pg8::Gemm g{1024, 1024, 1024};
        { pg8::Order S; S.init(10, 4, G, bx, 0, memn, T1K, 0, Wkv, T1K, 0); pg8::EpiPlain<false> E{Kmat, 1024, nullptr}; pg8::gemm_phase(lds, g, S, E); }
        { pg8::Order S; S.init(4, 10, G, (bx + G / 2) % G, 0, Wkv + (size_t)1024 * 1024, T1K, 0, memn, T1K, 0); pg8::EpiPlain<false> E{Vt, NMEMROWS, nullptr}; pg8::gemm_phase(lds, g, S, E); }
    }
    PH(2) {
        { pg8::Gemm g{1024, 1024, 1024}; pg8::Order S; S.init(256, 22, G, bx, 0, XB0, T1K, 0, Wgu1, T1K, 0);
          pg8::EpiGU E{R2, HTAIL, HSPLIT, ss0}; pg8::gemm_phase(lds, g, S, E); }
        xcd_barrier(xbar);
        { pg8::Gemm g{DFF, DFF, DFF}; pg8::Order S; S.init(256, 4, G, bx, 0, R2, 256u * DFF * 2u, 0, Wd1, 256u * DFF * 2u, 0); S.A2 = (const GAS char*)HTAIL; S.pmsplit = HSPLIT;
          pg8::EpiRes<true> E{INP(0), INP(1) - (size_t)T_HALF * DM, R1, ss1, 0.5f}; pg8::gemm_phase(lds, g, S, E); }
        xcd_barrier(xbar);
    }
    PH(3) { pg8::Gemm g{1024, 1024, 1024}; pg8::Order S; S.init(256, 10, G, bx, 0, R1, T1K, 0, Win, T1K, 0);
      pg8::EpiWin E{R2, ss1}; pg8::gemm_phase(lds, g, S, E); }
    xcd_barrier(xbar);
    PH(4) {
        const GAS bf16_t* MIX = R2; GAS bf16_t* YM = DO_LO;
        const GAS float* convw = INP(9); const GAS float* b_s = INP(11); const GAS float* ln_g = INP(12); const GAS float* ln_b = INP(13); const GAS float* g_co = INP(14); const GAS float* g_go = INP(15);
        LAS float* part = (LAS float*)(lds + LDS_PART_OFF);
        const int fr = lane & 15, fq = lane >> 4, h = wave, c8 = lane * 8;
        f32x4 ggo[4];
#pragma unroll
        for (int db = 0; db < 4; ++db) ggo[db] = *(const GAS f32x4*)(g_go + h * 64 + 16 * fq + 4 * db);
#define MIX_LOAD(T0_, I0_, GV_, CX_) do { const int tq_ = (T0_) + wave * 16 + (I0_); const int sm_ = (T0_) < T_HALF ? 4095 : 16383; \
            _Pragma("unroll") for (int u = 0; u < 4; ++u) { const GAS bf16_t* row = MIX + (size_t)(tq_ + u) * 2048; GV_[u] = *(const GAS u32x4*)(row + 1536 + c8); } \
            _Pragma("unroll") for (int j = 0; j < 6; ++j) { const int tt = tq_ - 1 + j; const bool ok = (tt & ~sm_) == ((T0_) & ~sm_); \
                const u32x4 ld = *(const GAS u32x4*)(MIX + (size_t)(ok ? tt : tq_) * 2048 + 512 + c8); \
                CX_[j].x = ok ? ld.x : 0u; CX_[j].y = ok ? ld.y : 0u; CX_[j].z = ok ? ld.z : 0u; CX_[j].w = ok ? ld.w : 0u; } } while (0)
        for (int ch = vcu; ch < T_TOK / 128; ch += G) {
            const int t0 = ch * 128;
            u32x4 gvv[4], cxv[6];
            MIX_LOAD(t0, 0, gvv, cxv);
#pragma unroll 1
            for (int i0 = 0; i0 < 16; i0 += 4) {
                const int q0 = wave * 16 + i0, tq = t0 + q0;
                u32x4 gvn[4], bgv[4], cxn[6];
                if (i0 < 12) MIX_LOAD(t0, i0 + 4, gvn, cxn);
#pragma unroll
                for (int u = 0; u < 4; ++u) bgv[u] = *(const GAS u32x4*)(MIX + (size_t)(tq + u) * 2048 + c8);
                float lg[8], lb[8];
#pragma unroll
                for (int e = 0; e < 8; ++e) { lg[e] = ln_g[c8 + e]; lb[e] = ln_b[c8 + e]; }
#pragma unroll
                for (int u = 0; u < 4; ++u) {
                    const u32x4 gv = gvv[u];
                    float v[8] = {bf_lo(gv.x), bf_hi(gv.x), bf_lo(gv.y), bf_hi(gv.y), bf_lo(gv.z), bf_hi(gv.z), bf_lo(gv.w), bf_hi(gv.w)};
                    float sm = 0.f;
#pragma unroll
                    for (int e = 0; e < 8; ++e) sm += v[e];
                    const float mean = wave_sum(sm) * (1.0f / 512.0f); float s2 = 0.f;
#pragma unroll
                    for (int e = 0; e < 8; ++e) { v[e] -= mean; s2 += v[e] * v[e]; }
                    const float rstd = rsqrtf(wave_sum(s2) * (1.0f / 512.0f) + EPS);
                    u32x2 w0, w1;
                    w0.x = cvt_pk_bf16(v[0] * rstd * lg[0] + lb[0], v[1] * rstd * lg[1] + lb[1]); w0.y = cvt_pk_bf16(v[2] * rstd * lg[2] + lb[2], v[3] * rstd * lg[3] + lb[3]);
                    w1.x = cvt_pk_bf16(v[4] * rstd * lg[4] + lb[4], v[5] * rstd * lg[5] + lb[5]); w1.y = cvt_pk_bf16(v[6] * rstd * lg[6] + lb[6], v[7] * rstd * lg[7] + lb[7]);
                    *(LAS u32x2*)(lds + (q0 + u) * MIXSTR + lane * 16) = w0; *(LAS u32x2*)(lds + (q0 + u) * MIXSTR + lane * 16 + 8) = w1;
                }
                asm volatile("" ::: "memory");
                float gc[8], cw0[8], cw1[8], cw2[8];
#pragma unroll
                for (int e = 0; e < 8; ++e) { gc[e] = g_co[c8 + e]; cw0[e] = convw[c8 + e]; cw1[e] = convw[512 + c8 + e]; cw2[e] = convw[1024 + c8 + e]; }
#pragma unroll
                for (int u = 0; u < 4; ++u) {
                    const u32x4 bg = bgv[u], cx0 = cxv[u], cx1 = cxv[u + 1], cx2 = cxv[u + 2];
                    const float B[8] = {bf_lo(bg.x), bf_hi(bg.x), bf_lo(bg.y), bf_hi(bg.y), bf_lo(bg.z), bf_hi(bg.z), bf_lo(bg.w), bf_hi(bg.w)};
                    const float X0[8] = {bf_lo(cx0.x), bf_hi(cx0.x), bf_lo(cx0.y), bf_hi(cx0.y), bf_lo(cx0.z), bf_hi(cx0.z), bf_lo(cx0.w), bf_hi(cx0.w)};
                    const float X1[8] = {bf_lo(cx1.x), bf_hi(cx1.x), bf_lo(cx1.y), bf_hi(cx1.y), bf_lo(cx1.z), bf_hi(cx1.z), bf_lo(cx1.w), bf_hi(cx1.w)};
                    const float X2[8] = {bf_lo(cx2.x), bf_hi(cx2.x), bf_lo(cx2.y), bf_hi(cx2.y), bf_lo(cx2.z), bf_hi(cx2.z), bf_lo(cx2.w), bf_hi(cx2.w)};
                    float y[8]; float sq = 0.f;
#pragma unroll
                    for (int e = 0; e < 8; ++e) { y[e] = B[e] * (cw0[e] * X0[e] + cw1[e] * X1[e] + cw2[e] * X2[e]); sq += y[e] * y[e]; }
                    const float sc = rsqrtf(wave_sum(sq) * (1.0f / 512.0f) + EPS);
                    u32x4 w; w.x = cvt_pk_bf16(y[0] * sc * gc[0], y[1] * sc * gc[1]); w.y = cvt_pk_bf16(y[2] * sc * gc[2], y[3] * sc * gc[3]);
                    w.z = cvt_pk_bf16(y[4] * sc * gc[4], y[5] * sc * gc[5]); w.w = cvt_pk_bf16(y[6] * sc * gc[6], y[7] * sc * gc[7]);
                    *(GAS u32x4*)(YM + (size_t)(tq + u) * DM + c8) = w;
                }
#pragma unroll
                for (int u = 0; u < 4; ++u) gvv[u] = gvn[u];
#pragma unroll
                for (int j = 0; j < 6; ++j) cxv[j] = cxn[j];
            }
            __syncthreads();
#pragma unroll 1
            for (int ph = 0; ph < 2; ++ph) {
                f32x4 acc[4][4]; u32x4 guv[4][2];
#pragma unroll
                for (int pb = 0; pb < 4; ++pb) {
#pragma unroll
                    for (int db = 0; db < 4; ++db) acc[pb][db] = (f32x4){0.f, 0.f, 0.f, 0.f};
                    const GAS bf16_t* gup = MIX + (size_t)(t0 + ph * 64 + pb * 16 + fr) * 2048 + 1024 + h * 64 + 16 * fq;
                    guv[pb][0] = *(const GAS u32x4*)gup; guv[pb][1] = *(const GAS u32x4*)(gup + 8);
                }
#pragma unroll
                for (int ks = 0; ks < 4; ++ks) {
                    bf16x8 vf[4];
#pragma unroll
                    for (int db = 0; db < 4; ++db)
#pragma unroll
                        for (int e = 0; e < 8; ++e) vf[db][e] = *(const LAS short*)(lds + (ks * 32 + fq * 8 + e) * MIXSTR + (h * 64 + 16 * (fr >> 2) + 4 * db + (fr & 3)) * 2);
#pragma unroll
                    for (int pb = 0; pb < 4; ++pb) {
                        const bf16x8 wf = *(const GAS bf16x8*)(Wsb + (size_t)(h * 128 + ph * 64 + pb * 16 + fr) * 128 + ks * 32 + fq * 8);
#pragma unroll
                        for (int db = 0; db < 4; ++db) acc[pb][db] = __builtin_amdgcn_mfma_f32_16x16x32_bf16(vf[db], wf, acc[pb][db], 0, 0, 0);
                    }
                }
#pragma unroll
                for (int pb = 0; pb < 4; ++pb) {
                    const int prow = ph * 64 + pb * 16 + fr; const float bsv = b_s[h * 128 + prow]; float q = 0.f;
#pragma unroll
                    for (int db = 0; db < 4; ++db) {
                        const u32x4 g4 = guv[pb][db >> 1]; const unsigned gx = (db & 1) ? g4.z : g4.x, gy = (db & 1) ? g4.w : g4.y;
                        f32x4 a = acc[pb][db];
                        a[0] = bf_lo(gx) * (a[0] + bsv); a[1] = bf_hi(gx) * (a[1] + bsv); a[2] = bf_lo(gy) * (a[2] + bsv); a[3] = bf_hi(gy) * (a[3] + bsv);
                        q += (a[0] * a[0] + a[1] * a[1]) + (a[2] * a[2] + a[3] * a[3]);
                        acc[pb][db] = a;
                    }
                    q += __shfl_xor(q, 16); q += __shfl_xor(q, 32);
                    if (fq == 0) part[prow * 8 + h] = q;
                }
                __syncthreads();
#pragma unroll
                for (int pb = 0; pb < 4; ++pb) {
                    const int prow = ph * 64 + pb * 16 + fr;
                    const f32x4 p0 = *(const LAS f32x4*)(part + prow * 8), p1 = *(const LAS f32x4*)(part + prow * 8 + 4);
                    const float sc = rsqrtf(((p0[0] + p0[1]) + (p0[2] + p0[3]) + (p1[0] + p1[1]) + (p1[2] + p1[3])) * (1.0f / 512.0f) + EPS);
                    GAS bf16_t* orow = YM + (size_t)(t0 + prow) * DM + 512 + h * 64 + 16 * fq;
                    unsigned ow[8];
#pragma unroll
                    for (int db = 0; db < 4; ++db) {
                        const f32x4 o = acc[pb][db] * sc * ggo[db];
                        ow[2 * db] = cvt_pk_bf16(o[0], o[1]); ow[2 * db + 1] = cvt_pk_bf16(o[2], o[3]);
                    }
                    *(GAS u32x4*)orow = (u32x4){ow[0], ow[1], ow[2], ow[3]}; *(GAS u32x4*)(orow + 8) = (u32x4){ow[4], ow[5], ow[6], ow[7]};
                }
            }
            __syncthreads();
        }
    }
    xcd_barrier(xbar);
    PH(5) { pg8::Gemm g{1024, 1024, 1024}; pg8::Order S; S.init(256, 4, G, bx, 0, DO_LO, T1K, 0, Wout, T1K, 0);
      pg8::EpiRes<false> E{R1, R1, R1, ss2, 1.0f}; pg8::gemm_phase(lds, g, S, E); }
    xcd_barrier(xbar);
    PH(6) { pg8::Gemm g{1024, 1024, 1024}; pg8::Order S; S.init(256, 4, G, bx, 0, R1, T1K, 0, Wq, T1K, 0);
      pg8::EpiPlain<true> E{DO_HI, 1024, ss2}; pg8::gemm_phase(lds, g, S, E); }
    LOCAL_SEAM();
    PH(7) { pg8::Gemm g{1024, 1024, 256}; pg8::Order S; S.init(256, 4, G, bx, 0, DO_HI, T1K, 512, Kmat, 512, T1K);
      pg8::EpiSoftmax E{R2, (LAS float*)(lds + LDS_RED_OFF)}; pg8::gemm_phase(lds, g, S, E); }
    LOCAL_SEAM();
    PH(8) { pg8::Gemm g{1024, NMEMROWS, 256}; pg8::Order S; S.init(256, 4, G, bx, 0, R2, T1K, 512, Vt, 256u * NMEMROWS * 2u, 512);
      pg8::EpiPlain<false> E{DO_LO, 1024, nullptr}; pg8::gemm_phase(lds, g, S, E); }
    xcd_barrier(xbar);
    PH(9) { pg8::Gemm g{1024, 1024, 1024}; pg8::Order S; S.init(256, 4, G, bx, 0, DO_LO, T1K, 0, Wo, T1K, 0);
      pg8::EpiRes<false> E{R1, R1, R1, ss3, 1.0f}; pg8::gemm_phase(lds, g, S, E); }
    xcd_barrier(xbar);
    {
        GAS bf16_t* H2T = (GAS bf16_t*)WSP(WS_H2TAIL) - (size_t)HSPLIT * 256 * DFF;
        PH(10) {
            { pg8::Gemm g{1024, 1024, 1024}; pg8::Order S; S.init(256, 22, G, bx, 0, R1, T1K, 0, Wgu2, T1K, 0);
              pg8::EpiGU E{R2, H2T, HSPLIT, ss3}; pg8::gemm_phase(lds, g, S, E); }
            xcd_barrier(xbar);
        }
        if (G == 256) {
            PH(10) { pg8::Gemm g{DFF, DFF, DFF}; pg8::Order S; S.init(256, 4, G, bx, 0, R2, 256u * DFF * 2u, 0, Wd2, 256u * DFF * 2u, 0); S.A2 = (const GAS char*)H2T; S.pmsplit = HSPLIT;
              pg8::EpiFinal E{R1, OUTP, INP(25), (float*)WSP(WS_XBUF), (unsigned*)WSP(WS_CNT), (LAS float*)(lds + LDS_RED_OFF), 0.5f}; pg8::gemm_phase(lds, g, S, E); }
        } else {
            PH(10) { pg8::Gemm g{DFF, DFF, DFF}; pg8::Order S; S.init(256, 4, G, bx, 0, R2, 256u * DFF * 2u, 0, Wd2, 256u * DFF * 2u, 0); S.A2 = (const GAS char*)H2T; S.pmsplit = HSPLIT;
              pg8::EpiRes<false> E{R1, R1, R1, ss4, 0.5f}; pg8::gemm_phase(lds, g, S, E); }
            xcd_barrier(xbar);
            PH(11) {
                const int gw = vcu * 8 + wave, NGW = G * 8; const GAS float* gf = INP(25); const GAS bf16_t* X4 = R1; GAS float* xo = OUTP; const GAS float* s4 = ss4;
                for (int m = gw; m < T_TOK; m += NGW) {
                    const float sc = rsqrtf(s4[m] * (1.0f / 1024.0f) + EPS);
#pragma unroll
                    for (int j = 0; j < 2; ++j) { const int c = 8 * lane + 512 * j; const u32x4 xb = *(const GAS u32x4*)(X4 + (size_t)m * DM + c);
                        const f32x4 g0 = *(const GAS f32x4*)(gf + c), g1 = *(const GAS f32x4*)(gf + c + 4);
                        *(GAS f32x4*)(xo + (size_t)m * DM + c) = (f32x4){bf_lo(xb.x), bf_hi(xb.x), bf_lo(xb.y), bf_hi(xb.y)} * sc * g0;
                        *(GAS f32x4*)(xo + (size_t)m * DM + c + 4) = (f32x4){bf_lo(xb.z), bf_hi(xb.z), bf_lo(xb.w), bf_hi(xb.w)} * sc * g1; }
                }
            }
        }
    }
}

extern "C" void kernel_launch(void* const* d_in, const int* in_sizes, int n_in, void* d_out, int out_size, void* d_ws, size_t ws_size, hipStream_t stream) {
    static int grid_blocks = 0;
    if (grid_blocks == 0) {
        if (n_in != 26 || ws_size < WS_END) { fprintf(stderr, "kernel_launch: unexpected n_in %d / ws_size %zu\n", n_in, ws_size); grid_blocks = -1; return; }
        int dev = 0, cus = 0, per_cu = 0;
        hipGetDevice(&dev);
        hipDeviceGetAttribute(&cus, hipDeviceAttributeMultiprocessorCount, dev);
        if (hipFuncSetAttribute((const void*)mega_fwd, hipFuncAttributeMaxDynamicSharedMemorySize, LDS_BYTES) != hipSuccess) { fprintf(stderr, "kernel_launch: hipFuncSetAttribute failed\n"); grid_blocks = -1; return; }
        if (hipOccupancyMaxActiveBlocksPerMultiprocessor(&per_cu, (const void*)mega_fwd, 512, LDS_BYTES) != hipSuccess || per_cu < 1) { fprintf(stderr, "kernel_launch: occupancy query gives %d\n", per_cu); per_cu = 1; }
        (void)hipGetLastError();
        grid_blocks = cus * 1;
    }
    if (grid_blocks < 0) return;
    Params p{};
    for (int i = 0; i < 26; ++i) p.in[i] = (const float*)d_in[i];
    p.out = (float*)d_out; p.ws = (unsigned char*)d_ws;
    void* args[] = {&p};
    hipError_t e = hipLaunchCooperativeKernel((const void*)mega_fwd, dim3(grid_blocks), dim3(512), args, LDS_BYTES, stream);
    if (e != hipSuccess) fprintf(stderr, "cooperative launch failed: %s (grid %d)\n", hipGetErrorString(e), grid_blocks);
}
```
